# Optimizing an MI355X kernel written in HIP

```python
import math
import jax, jax.numpy as jnp
from jax import lax
import numpy as np

D_MODEL = 4096
BATCH = 4
SEQ = 4096
DEPTH = 1

CHUNK = 64
N_META = 16
Q_BLOCK = 128
NEG_INF = -1e30
RMS_EPS = 1e-6

MIX_WIDTH = D_MODEL
DIFF_WIDTH = MIX_WIDTH // 2
MLA_WIDTH = MIX_WIDTH - DIFF_WIDTH

DIFF_HEAD_DIM = 128
DIFF_V_DIM = 2 * DIFF_HEAD_DIM
DIFF_HEADS = DIFF_WIDTH // DIFF_V_DIM
DIFF_QK_WIDTH = DIFF_HEADS * 2 * DIFF_HEAD_DIM

MLA_NOPE = 128
MLA_ROPE = 64
MLA_V_DIM = 128
MLA_HEADS = MLA_WIDTH // MLA_V_DIM
Q_LORA = 1536
KV_LORA = 512
ROPE_THETA = 10000.0

IN_SIZES = (DIFF_QK_WIDTH, DIFF_QK_WIDTH, DIFF_WIDTH, DIFF_WIDTH,
            Q_LORA, KV_LORA, MLA_ROPE, MLA_WIDTH)
IN_WIDTH = sum(IN_SIZES)

kernel_name = 'hybrid_diffattn_mla_meta_chunk_causal'


def _rms_norm(x, g):
    xf = x.astype(jnp.float32)
    y = xf * lax.rsqrt(jnp.mean(xf * xf, axis=-1, keepdims=True) + RMS_EPS)
    return (y * g.astype(jnp.float32)).astype(x.dtype)


def _rope(x, cos, sin):
    half = x.shape[-1] // 2
    x1, x2 = x[..., :half], x[..., half:]
    c = cos.astype(x.dtype)
    s = sin.astype(x.dtype)
    return jnp.concatenate([x1 * c - x2 * s, x1 * s + x2 * c], axis=-1)


def _alibi_slopes(n_heads):
    return 2.0 ** (-8.0 * jnp.arange(1, n_heads + 1, dtype=jnp.float32) / n_heads)


def _chunk_id(pos):
    return jnp.where(pos < N_META, 0, (pos - N_META) // CHUNK + 1)


def _chunk_causal_mask(q_pos, k_pos):
    return _chunk_id(k_pos)[None, :] <= _chunk_id(q_pos)[:, None]


def _sweep(attend, q_arrays, pos):
    meta_out = attend(tuple(q[:, :N_META] for q in q_arrays), pos[:N_META], N_META)
    total = pos.shape[0]
    n_blk = (total - N_META) // Q_BLOCK

    def to_blocks(q):
        r = q[:, N_META:]
        r = r.reshape((r.shape[0], n_blk, Q_BLOCK) + r.shape[2:])
        return jnp.moveaxis(r, 1, 0)

    blocks = tuple(to_blocks(q) for q in q_arrays)
    pos_blocks = pos[N_META:].reshape(n_blk, Q_BLOCK)
    out = lax.map(lambda xs: attend(xs[:-1], xs[-1], total), blocks + (pos_blocks,))
    out = jnp.moveaxis(out, 0, 1)
    out = out.reshape((out.shape[0], n_blk * Q_BLOCK) + out.shape[3:])
    return jnp.concatenate([meta_out, out], axis=1)


def _diff_attention(q, k, v, lam, pos, slopes):
    scale = DIFF_HEAD_DIM ** -0.5

    def attend(qb, q_pos, n_keys):
        (qb,) = qb
        kb = k[:, :n_keys]
        vb = v[:, :n_keys]
        k_pos = pos[:n_keys]
        dist = jnp.abs(q_pos[:, None] - k_pos[None, :]).astype(jnp.float32)
        bias = -slopes[:, None, None] * dist[None]
        s = jnp.einsum('bqhmd,bkhmd->bmhqk', qb, kb,
                       preferred_element_type=jnp.float32) * scale + bias
        s = jnp.where(_chunk_causal_mask(q_pos, k_pos), s, NEG_INF)
        p = jax.nn.softmax(s, axis=-1)
        w = p[:, 0] - lam * p[:, 1]
        return jnp.einsum('bhqk,bkhe->bqhe', w.astype(vb.dtype), vb)

    return _sweep(attend, (q,), pos)


def _mla_attention(q_nope, q_rope, k_nope, k_rope, v, pos):
    scale = (MLA_NOPE + MLA_ROPE) ** -0.5

    def attend(qb, q_pos, n_keys):
        qn, qr = qb
        k_pos = pos[:n_keys]
        s = (jnp.einsum('bqhd,bkhd->bhqk', qn, k_nope[:, :n_keys], preferred_element_type=jnp.float32)
             + jnp.einsum('bqhr,bkr->bhqk', qr, k_rope[:, :n_keys], preferred_element_type=jnp.float32)) * scale
        s = jnp.where(_chunk_causal_mask(q_pos, k_pos), s, NEG_INF)
        p = jax.nn.softmax(s, axis=-1)
        vb = v[:, :n_keys]
        return jnp.einsum('bhqk,bkhe->bqhe', p.astype(vb.dtype), vb)

    return _sweep(attend, (q_nope, q_rope), pos)


def _hybrid_layer(h, pos, cos, sin, slopes, lambda_init, norm_pre, w_in,
                  lq1, lk1, lq2, lk2, subln, g_cq, g_ckv, w_uq, w_ukv, w_out, norm_post):
    b, l, _ = h.shape
    u = _rms_norm(h, norm_pre)
    z = jnp.einsum('bld,de->ble', u, w_in)
    points = []
    acc = 0
    for size in IN_SIZES[:-1]:
        acc += size
        points.append(acc)
    dq, dk, dv, dg, cq, ckv, kr, mg = jnp.split(z, points, axis=-1)

    dq = dq.reshape(b, l, DIFF_HEADS, 2, DIFF_HEAD_DIM)
    dk = dk.reshape(b, l, DIFF_HEADS, 2, DIFF_HEAD_DIM)
    dv = dv.reshape(b, l, DIFF_HEADS, DIFF_V_DIM)
    f32 = jnp.float32
    lam = (jnp.exp(jnp.sum(lq1.astype(f32) * lk1.astype(f32)))
           - jnp.exp(jnp.sum(lq2.astype(f32) * lk2.astype(f32))) + lambda_init)
    oa = _diff_attention(dq, dk, dv, lam, pos, slopes)
    oa = _rms_norm(oa, subln) * (1.0 - lambda_init)
    out_a = oa.reshape(b, l, DIFF_WIDTH) * jax.nn.silu(dg)

    cq = _rms_norm(cq, g_cq)
    q = jnp.einsum('blr,re->ble', cq, w_uq).reshape(b, l, MLA_HEADS, MLA_NOPE + MLA_ROPE)
    q_nope, q_rope = q[..., :MLA_NOPE], q[..., MLA_NOPE:]
    q_rope = _rope(q_rope, cos[:, None, :], sin[:, None, :])
    ckv = _rms_norm(ckv, g_ckv)
    kv = jnp.einsum('blr,re->ble', ckv, w_ukv).reshape(b, l, MLA_HEADS, MLA_NOPE + MLA_V_DIM)
    k_nope, v = kv[..., :MLA_NOPE], kv[..., MLA_NOPE:]
    k_rope = _rope(kr, cos, sin)
    ob = _mla_attention(q_nope, q_rope, k_nope, k_rope, v, pos)
    out_b = ob.reshape(b, l, MLA_WIDTH) * jax.nn.silu(mg)

    mix = jnp.concatenate([out_a, out_b], axis=-1)
    y = jnp.einsum('ble,ed->bld', mix, w_out)
    return h + _rms_norm(y, norm_post)


def setup_inputs(seed: int = 0) -> dict:
    key = jax.random.key(seed)
    ks = jax.random.split(key, 16)
    f32 = jnp.float32
    nrm = lambda k, shape, s: jax.random.normal(k, shape, f32) * s
    gain = lambda k, shape: 1.0 + 0.02 * jax.random.normal(k, shape, f32)
    return {
        'x': nrm(ks[0], (BATCH, SEQ, D_MODEL), 1.0),
        'meta_tokens': nrm(ks[1], (N_META, D_MODEL), 1.0),
        'norm_pre': gain(ks[2], (DEPTH, D_MODEL)),
        'w_in': nrm(ks[3], (DEPTH, D_MODEL, IN_WIDTH), D_MODEL ** -0.5),
        'diff_lambda_q1': nrm(ks[4], (DEPTH, DIFF_HEAD_DIM), 0.1),
        'diff_lambda_k1': nrm(ks[5], (DEPTH, DIFF_HEAD_DIM), 0.1),
        'diff_lambda_q2': nrm(ks[6], (DEPTH, DIFF_HEAD_DIM), 0.1),
        'diff_lambda_k2': nrm(ks[7], (DEPTH, DIFF_HEAD_DIM), 0.1),
        'diff_subln': gain(ks[8], (DEPTH, DIFF_V_DIM)),
        'mla_norm_q': gain(ks[9], (DEPTH, Q_LORA)),
        'mla_norm_kv': gain(ks[10], (DEPTH, KV_LORA)),
        'w_uq': nrm(ks[11], (DEPTH, Q_LORA, MLA_HEADS * (MLA_NOPE + MLA_ROPE)), Q_LORA ** -0.5),
        'w_ukv': nrm(ks[12], (DEPTH, KV_LORA, MLA_HEADS * (MLA_NOPE + MLA_V_DIM)), KV_LORA ** -0.5),
        'w_out': nrm(ks[13], (DEPTH, MIX_WIDTH, D_MODEL), MIX_WIDTH ** -0.5),
        'norm_post': gain(ks[14], (DEPTH, D_MODEL)),
    }


def reference(x, meta_tokens, norm_pre, w_in, diff_lambda_q1, diff_lambda_k1, diff_lambda_q2,
              diff_lambda_k2, diff_subln, mla_norm_q, mla_norm_kv, w_uq, w_ukv, w_out, norm_post):
    b = x.shape[0]
    meta = jnp.broadcast_to(meta_tokens[None].astype(x.dtype), (b, N_META, x.shape[-1]))
    h = jnp.concatenate([meta, x], axis=1)
    total = h.shape[1]
    pos = jnp.arange(total, dtype=jnp.int32)
    inv_freq = 1.0 / (ROPE_THETA ** (jnp.arange(0, MLA_ROPE, 2, dtype=jnp.float32) / MLA_ROPE))
    ang = pos.astype(jnp.float32)[:, None] * inv_freq[None, :]
    cos, sin = jnp.cos(ang), jnp.sin(ang)
    slopes = _alibi_slopes(DIFF_HEADS)
    for layer in range(DEPTH):
        lambda_init = 0.8 - 0.6 * math.exp(-0.3 * layer)
        h = _hybrid_layer(h, pos, cos, sin, slopes, lambda_init, norm_pre[layer], w_in[layer],
                          diff_lambda_q1[layer], diff_lambda_k1[layer], diff_lambda_q2[layer],
                          diff_lambda_k2[layer], diff_subln[layer], mla_norm_q[layer],
                          mla_norm_kv[layer], w_uq[layer], w_ukv[layer], w_out[layer], norm_post[layer])
    return h[:, N_META:]
```

```cpp
#include <hip/hip_runtime.h>
#include <hip/hip_cooperative_groups.h>
#include <cstdio>
#include <cstdint>
namespace cg = cooperative_groups;
namespace pg8 {
#define PG8_LAS __attribute__((address_space(3)))
typedef unsigned short bf16_t;
typedef short bf16x8 __attribute__((ext_vector_type(8)));
typedef float f32x4 __attribute__((ext_vector_type(4)));
typedef unsigned u32x4 __attribute__((ext_vector_type(4)));
constexpr int BM = 256, BK = 64, HALF = 128, HTB = HALF * BK * 2  , STAGE_BYTES = 8 * HTB, NXCD = 8, WGM = 8;

__host__ __device__ __forceinline__ int lds_byte(int r, int c) { const int st = (r >> 4) * 2 + (c >> 5), rr = r & 15, cc = c & 31, ob = rr * 64 + cc * 2; return st * 1024 + (ob ^ (((ob >> 9) & 1) << 5)); }
__host__ __device__ __forceinline__ void stage_rc(int b, int& R, int& C) { const int st = b / 1024, sb = b % 1024, swz = sb ^ (((sb >> 9) & 1) << 5); R = (st >> 1) * 16 + swz / 64; C = (st & 1) * 32 + (swz % 64) / 2; }
__host__ __device__ __forceinline__ int perm32(int rho) { const int n = rho >> 4, i = rho & 15; return 8 * (i >> 2) + 4 * n + (i & 3); }

struct Unit { int pm, pn; };
struct Gemm { const bf16_t* A; const bf16_t* Bt; int M, N, K; };

struct StaticOrder {
    int nM, nN, nwg, G, c;
    __host__ __device__ void init(int M, int N, int G_, int c_) { nM = M / BM; nN = N / BM; nwg = nM * nN; G = G_; c = c_; }
    __host__ __device__ bool next(int i, Unit& u) const {
        const long L = (long)i * G + c; if (L >= nwg) return false;
        int wgid = (int)L; { const int q = nwg / NXCD, r = nwg % NXCD, xcd = wgid % NXCD, off = wgid / NXCD; wgid = (xcd < r ? xcd * (q + 1) : r * (q + 1) + (xcd - r) * q) + off; }
        const int nig = WGM * nN, gid = wgid / nig, fm = gid * WGM, gsz = (nM - fm) < WGM ? (nM - fm) : WGM;
        u.pm = fm + ((wgid % nig) % gsz); u.pn = (wgid % nig) / gsz; return true;
    }
    __device__ __forceinline__ void a_ready(const Unit&) const {}
    __device__ __forceinline__ void done(const Unit&) const {}
};

__device__ __forceinline__ unsigned cvt_pk_bf16(float lo, float hi) { unsigned r; asm volatile("v_cvt_pk_bf16_f32 %0, %1, %2" : "=v"(r) : "v"(lo), "v"(hi)); return r; }
typedef float f32x2 __attribute__((ext_vector_type(2)));
__device__ __forceinline__ f32x2 gelu_pk(f32x2 v) {
    const f32x2 av = __builtin_elementwise_abs(v), d = av * 0.2316418882f + 1.0f;
    f32x2 t; t.x = __builtin_amdgcn_rcpf(d.x); t.y = __builtin_amdgcn_rcpf(d.y);
    f32x2 q = t * 0.5307027145f + (-0.7265760135f); q = q * t + 0.7107068705f; q = q * t + (-0.142248368f); q = q * t + 0.127414796f; q = q * t;
    const f32x2 s = (v * v) * (-0.72134752044f);
    f32x2 e; e.x = __builtin_amdgcn_exp2f(s.x); e.y = __builtin_amdgcn_exp2f(s.y);
    const f32x2 m = v * (q * e), r = v - m;
    f32x2 o; o.x = v.x < 0.f ? m.x : r.x; o.y = v.y < 0.f ? m.y : r.y; return o;
}

template <int ACT  > struct EpiBf16 {
    static constexpr bool PERM = true, AFTER_DRAIN = false; static_assert(ACT == 0 || ACT == 1, "EpiBf16: ACT is 0 (none) or 1 (gelu_pk)");
    bf16_t* O; int ldc; const float* bias; int split_cols; size_t split_stride; float scale0;
    __device__ __forceinline__ void operator()(const f32x4 (&acc)[2][2][4][2], const Unit& u, int wr, int wc, int fr, int fq) const {
        const int row0 = u.pm * BM + wr * 64 + fr; int colt = u.pn * BM; bf16_t* base = O;
        float sc = 1.f; if (split_cols) { const int t = colt / split_cols; base += (size_t)t * split_stride; colt -= t * split_cols; if (t == 0) sc = scale0; }
        const int col0 = colt + wc * 32 + 8 * fq, bcol0 = u.pn * BM + wc * 32 + 8 * fq;
        f32x4 bv[2][2];
#pragma unroll
        for (int bj = 0; bj < 2; ++bj)
#pragma unroll
            for (int n = 0; n < 2; ++n) bv[bj][n] = bias ? *(const f32x4*)(bias + bcol0 + bj * HALF + 4 * n) : (f32x4){0.f, 0.f, 0.f, 0.f};
#pragma unroll
        for (int ai = 0; ai < 2; ++ai)
#pragma unroll
            for (int m = 0; m < 4; ++m) { bf16_t* rowp = base + (size_t)(row0 + ai * HALF + m * 16) * ldc + col0;
#pragma unroll
                for (int bj = 0; bj < 2; ++bj) { f32x4 v0 = acc[ai][bj][m][0] + bv[bj][0], v1 = acc[ai][bj][m][1] + bv[bj][1];
                    if (ACT == 1) { f32x2 a = gelu_pk((f32x2){v0[0], v0[1]}), b = gelu_pk((f32x2){v0[2], v0[3]}), c = gelu_pk((f32x2){v1[0], v1[1]}), d = gelu_pk((f32x2){v1[2], v1[3]});
                        v0 = (f32x4){a.x, a.y, b.x, b.y}; v1 = (f32x4){c.x, c.y, d.x, d.y}; }
                    v0 = v0 * sc; v1 = v1 * sc; u32x4 w; w.x = cvt_pk_bf16(v0[0], v0[1]); w.y = cvt_pk_bf16(v0[2], v0[3]); w.z = cvt_pk_bf16(v1[0], v1[1]); w.w = cvt_pk_bf16(v1[2], v1[3]);
                    *(u32x4*)(rowp + bj * HALF) = w; } }
    }
};
__device__ __forceinline__ u32x4 pack8s(f32x4 v0, f32x4 v1, float sc) {
    v0 = v0 * sc; v1 = v1 * sc; u32x4 w; w.x = cvt_pk_bf16(v0[0], v0[1]); w.y = cvt_pk_bf16(v0[2], v0[3]); w.z = cvt_pk_bf16(v1[0], v1[1]); w.w = cvt_pk_bf16(v1[2], v1[3]); return w;
}
__device__ __forceinline__ u32x4 rope8(f32x4 v0, f32x4 v1, const float* cosT, const float* sinT, int pos, int i0, float sc) {
    const f32x4 cs = *(const f32x4*)(cosT + pos * 32 + i0), sn = *(const f32x4*)(sinT + pos * 32 + i0);
    f32x4 a, b;
    a[0] = v0[0] * cs[0] - v0[1] * sn[0]; a[1] = v0[0] * sn[0] + v0[1] * cs[0];
    a[2] = v0[2] * cs[1] - v0[3] * sn[1]; a[3] = v0[2] * sn[1] + v0[3] * cs[1];
    b[0] = v1[0] * cs[2] - v1[1] * sn[2]; b[1] = v1[0] * sn[2] + v1[1] * cs[2];
    b[2] = v1[2] * cs[3] - v1[3] * sn[3]; b[3] = v1[2] * sn[3] + v1[3] * cs[3];
    return pack8s(a, b, sc);
}
struct EpiZ {
    static constexpr bool PERM = true, AFTER_DRAIN = false;
    static constexpr size_t MPR = 16640;
    bf16_t *QD, *KD, *VD, *GD, *CQ, *CKV, *GM, *KR; const float* cosT; const float* sinT; float scq;
    __device__ __forceinline__ void operator()(const f32x4 (&acc)[2][2][4][2], const Unit& u, int wr, int wc, int fr, int fq) const {
        const int colt = u.pn * BM; bf16_t* base; int ldc, c0; float sc = 1.f; bool rope = false;
        bool hm = false;
        if (colt < 2048) { base = QD + (size_t)(colt >> 8) * 2 * MPR * 128; hm = true; sc = scq; ldc = 128; c0 = 0; }
        else if (colt < 4096) { base = KD + (size_t)((colt - 2048) >> 8) * 2 * MPR * 128; hm = true; ldc = 128; c0 = 0; }
        else if (colt < 6144) { base = VD + (size_t)((colt - 4096) >> 8) * 2 * MPR * 128; hm = true; ldc = 128; c0 = 0; }
        else if (colt < 8192) { base = GD; ldc = 2048; c0 = colt - 6144; }
        else if (colt < 9728) { base = CQ; ldc = 1536; c0 = colt - 8192; }
        else if (colt < 10240) { base = CKV; ldc = 512; c0 = colt - 9728; }
        else if (colt < 12288) { base = GM; ldc = 2048; c0 = colt - 10240; }
        else { base = KR; ldc = 64; c0 = 0; rope = true; }
        const int row0 = u.pm * BM + wr * 64 + fr, lc = wc * 32 + 8 * fq;
        if (!rope) {
#pragma unroll
            for (int ai = 0; ai < 2; ++ai)
#pragma unroll
                for (int m = 0; m < 4; ++m) { bf16_t* rowp = base + (size_t)(row0 + ai * HALF + m * 16) * ldc + c0 + lc;
#pragma unroll
                    for (int bj = 0; bj < 2; ++bj) *(u32x4*)(rowp + (hm ? (size_t)bj * MPR * 128 : (size_t)(bj * HALF))) = pack8s(acc[ai][bj][m][0], acc[ai][bj][m][1], sc); }
        } else if (wc < 2) {
#pragma unroll
            for (int ai = 0; ai < 2; ++ai)
#pragma unroll
                for (int m = 0; m < 4; ++m) { const int row = row0 + ai * HALF + m * 16; const int pos = row < 16384 ? 16 + (row & 4095) : ((row - 16384) & 63);
                    *(u32x4*)(base + (size_t)row * 64 + lc) = rope8(acc[ai][0][m][0], acc[ai][0][m][1], cosT, sinT, pos, lc >> 1, 1.f); }
        }
    }
};
struct EpiQ {
    static constexpr bool PERM = true, AFTER_DRAIN = false;
    bf16_t *QN, *QR; const float* cosT; const float* sinT; float sc;
    __device__ __forceinline__ void operator()(const f32x4 (&acc)[2][2][4][2], const Unit& u, int wr, int wc, int fr, int fq) const {
        const int colt = u.pn * BM; const int row0 = u.pm * BM + wr * 64 + fr, lc = wc * 32 + 8 * fq;
        if (colt < 2048) {
#pragma unroll
            for (int ai = 0; ai < 2; ++ai)
#pragma unroll
                for (int m = 0; m < 4; ++m) { bf16_t* rowp = QN + ((size_t)(2 * u.pn) * 16384 + (size_t)(row0 + ai * HALF + m * 16)) * 128 + lc;
#pragma unroll
                    for (int bj = 0; bj < 2; ++bj) *(u32x4*)(rowp + (size_t)bj * 16384 * 128) = pack8s(acc[ai][bj][m][0], acc[ai][bj][m][1], sc); }
        } else {
            const int c0 = colt - 2048;
#pragma unroll
            for (int ai = 0; ai < 2; ++ai)
#pragma unroll
                for (int m = 0; m < 4; ++m) { const int row = row0 + ai * HALF + m * 16; const int pos = 16 + (row & 4095);
#pragma unroll
                    for (int bj = 0; bj < 2; ++bj) { const int cl = c0 + bj * HALF + lc;
                        *(u32x4*)(QR + ((size_t)(cl >> 6) * 16384 + row) * 64 + (cl & 63)) = rope8(acc[ai][bj][m][0], acc[ai][bj][m][1], cosT, sinT, pos, (cl & 63) >> 1, sc); } }
        }
    }
};
struct EpiKV {
    static constexpr bool PERM = true, AFTER_DRAIN = false;
    bf16_t* KVh;
    __device__ __forceinline__ void operator()(const f32x4 (&acc)[2][2][4][2], const Unit& u, int wr, int wc, int fr, int fq) const {
        const int row0 = u.pm * BM + wr * 64 + fr, lc = wc * 32 + 8 * fq;
#pragma unroll
        for (int ai = 0; ai < 2; ++ai)
#pragma unroll
            for (int m = 0; m < 4; ++m) { bf16_t* rowp = KVh + ((size_t)(2 * u.pn) * 16640 + (size_t)(row0 + ai * HALF + m * 16)) * 128 + lc;
#pragma unroll
                for (int bj = 0; bj < 2; ++bj) *(u32x4*)(rowp + (size_t)bj * 16640 * 128) = pack8s(acc[ai][bj][m][0], acc[ai][bj][m][1], 1.f); }
    }
};
struct EpiY {
    static constexpr bool PERM = true, AFTER_DRAIN = false;
    float* Y; int ldc;
    __device__ __forceinline__ void operator()(const f32x4 (&acc)[2][2][4][2], const Unit& u, int wr, int wc, int fr, int fq) const {
        const int row0 = u.pm * BM + wr * 64 + fr, col0 = u.pn * BM + wc * 32 + 8 * fq;
#pragma unroll
        for (int ai = 0; ai < 2; ++ai)
#pragma unroll
            for (int m = 0; m < 4; ++m) { float* rowp = Y + (size_t)(row0 + ai * HALF + m * 16) * ldc + col0;
#pragma unroll
                for (int bj = 0; bj < 2; ++bj) { *(f32x4*)(rowp + bj * HALF) = acc[ai][bj][m][0]; *(f32x4*)(rowp + bj * HALF + 4) = acc[ai][bj][m][1]; } }
    }
};

template <class Epi, class Sched, bool ALIGN_EPI = false, bool SP2 = false>
__device__ __forceinline__ void gemm_phase(PG8_LAS unsigned char* lds, const Gemm g, const Sched& S, const Epi& E, const int wid_arg) {
    const int wid = wid_arg, lane = (int)__builtin_amdgcn_mbcnt_hi(~0u, __builtin_amdgcn_mbcnt_lo(~0u, 0u)), tid = wid * 64 + lane, wr = wid >> 2, wc = wid & 3, fr = lane & 15, fq = lane >> 4;
    const int K = g.K, nt = K / BK;
    unsigned voffA[2], voffB[2];
#pragma unroll
    for (int i = 0; i < 2; ++i) { int R, C; stage_rc(tid * 16 + i * 8192, R, C); const int Rb = Epi::PERM ? ((R & ~31) + perm32(R & 31)) : R;
        voffA[i] = (unsigned)(R * K + C) * 2u; voffB[i] = (unsigned)(Rb * K + C) * 2u; }
    const size_t kstep = (size_t)(BK * 2);
    const size_t hstep = (size_t)HALF * K * 2;
    const size_t tstep = 2 * hstep;
    const unsigned ldsw = (unsigned)wid * 1024u;
    const int aoff = lds_byte(wr * 64 + fr, fq * 8), boff = lds_byte(wc * 32 + fr, fq * 8);
#define PG8_SA(b, h) (((b) * 2 + (h)) * HTB)
#define PG8_SB(b, h) ((4 + (b) * 2 + (h)) * HTB)
#define PG8_STAGE(bufoff, gbase, voff) do { _Pragma("unroll") for (int _i = 0; _i < 2; ++_i) \
        __builtin_amdgcn_global_load_lds((const unsigned*)((const char*)(gbase) + (voff)[_i]), (PG8_LAS unsigned*)(lds + (bufoff) + ldsw + _i * 8192), 16, 0, 0); } while (0)
#define PG8_LDA(dst, b, h) do { _Pragma("unroll") for (int m = 0; m < 4; ++m) _Pragma("unroll") for (int k = 0; k < 2; ++k) dst[m][k] = *(const PG8_LAS bf16x8*)(lds + PG8_SA(b, h) + aoff + m * 2048 + k * 1024); } while (0)
#define PG8_LDB(dst, b, h) do { _Pragma("unroll") for (int n = 0; n < 2; ++n) _Pragma("unroll") for (int k = 0; k < 2; ++k) dst[n][k] = *(const PG8_LAS bf16x8*)(lds + PG8_SB(b, h) + boff + n * 2048 + k * 1024); } while (0)
#define PG8_MMA(ai, bj, At, Bt) do { __builtin_amdgcn_s_setprio(1); _Pragma("unroll") for (int m = 0; m < 4; ++m) _Pragma("unroll") for (int n = 0; n < 2; ++n) _Pragma("unroll") for (int k = 0; k < 2; ++k) \
        acc[ai][bj][m][n] = __builtin_amdgcn_mfma_f32_16x16x32_bf16(Bt[n][k], At[m][k], acc[ai][bj][m][n], 0, 0, 0); __builtin_amdgcn_s_setprio(0); } while (0)
#define PG8_WAIT_V(n) asm volatile("s_waitcnt vmcnt(" #n ")" ::: "memory")
#define PG8_WAIT_L(n) asm volatile("s_waitcnt lgkmcnt(" #n ")" ::: "memory")
#define PG8_BAR __builtin_amdgcn_s_barrier()
#define PG8_SCHED __builtin_amdgcn_sched_barrier(0)
    Unit cur, nxt; int ui = 0;
    if (!S.next(0, cur)) return;
    f32x4 acc[2][2][4][2];
#pragma unroll
    for (int a = 0; a < 2; ++a)
#pragma unroll
        for (int b = 0; b < 2; ++b)
#pragma unroll
            for (int m = 0; m < 4; ++m)
#pragma unroll
                for (int n = 0; n < 2; ++n) acc[a][b][m][n] = (f32x4){0.f, 0.f, 0.f, 0.f};
    bf16x8 At[4][2], B0[2][2], B1[2][2];
    const char* cA = (const char*)g.A + (size_t)cur.pm * tstep; const char* cB = (const char*)g.Bt + (size_t)cur.pn * tstep;
    S.a_ready(cur);
    if constexpr (SP2) {
        PG8_STAGE(PG8_SB(0, 0), cB, voffB); PG8_STAGE(PG8_SB(0, 1), cB + hstep, voffB); PG8_STAGE(PG8_SA(0, 0), cA, voffA); PG8_STAGE(PG8_SA(0, 1), cA + hstep, voffA);
        if (wr == 1) PG8_BAR;
        PG8_WAIT_V(2); PG8_BAR;
        PG8_STAGE(PG8_SB(1, 0), cB + kstep, voffB); PG8_STAGE(PG8_SA(1, 0), cA + kstep, voffA); PG8_STAGE(PG8_SB(1, 1), cB + hstep + kstep, voffB);
        PG8_WAIT_V(6); PG8_BAR;
    } else {
        PG8_STAGE(PG8_SB(0, 0), cB, voffB); PG8_STAGE(PG8_SA(0, 0), cA, voffA); PG8_STAGE(PG8_SB(0, 1), cB + hstep, voffB); PG8_STAGE(PG8_SA(0, 1), cA + hstep, voffA);
        if (wr == 1) PG8_BAR;
        PG8_WAIT_V(4); PG8_BAR;
        PG8_STAGE(PG8_SB(1, 0), cB + kstep, voffB); PG8_STAGE(PG8_SA(1, 0), cA + kstep, voffA); PG8_STAGE(PG8_SB(1, 1), cB + hstep + kstep, voffB);
        PG8_WAIT_V(6); PG8_BAR;
    }
    for (;;) {
        const bool has_next = S.next(ui + 1, nxt);
        const char* nA = has_next ? (const char*)g.A + (size_t)nxt.pm * tstep : cA; const char* nB = has_next ? (const char*)g.Bt + (size_t)nxt.pn * tstep : cB;
        for (int t = 0; t < nt; t += 2) {
            const bool last = (t == nt - 2);
            const char* a1 = cA + (size_t)(t + 1) * kstep;
            const char* a2 = last ? nA : cA + (size_t)(t + 2) * kstep; const char* b2 = last ? nB : cB + (size_t)(t + 2) * kstep;
            const char* a3 = a2 + kstep; const char* b3 = b2 + kstep;
            if (last && has_next) S.a_ready(nxt);
            if constexpr (SP2) {
            PG8_LDB(B0, 0, 0); PG8_LDB(B1, 0, 1); PG8_SCHED; PG8_LDA(At, 0, 0); PG8_STAGE(PG8_SA(1, 1), a1 + hstep, voffA);
            PG8_WAIT_V(8); PG8_WAIT_L(0); PG8_BAR; PG8_MMA(0, 0, At, B0); PG8_MMA(0, 1, At, B1); PG8_BAR; PG8_SCHED;
            PG8_LDA(At, 0, 1); PG8_STAGE(PG8_SB(0, 0), b2, voffB); PG8_STAGE(PG8_SB(0, 1), b2 + hstep, voffB); PG8_STAGE(PG8_SA(0, 0), a2, voffA);
            PG8_WAIT_V(8); PG8_WAIT_L(0); PG8_BAR; PG8_MMA(1, 0, At, B0); PG8_MMA(1, 1, At, B1); PG8_BAR; PG8_SCHED;
            PG8_LDB(B0, 1, 0); PG8_LDB(B1, 1, 1); PG8_SCHED; PG8_LDA(At, 1, 0); PG8_STAGE(PG8_SA(0, 1), a2 + hstep, voffA);
            PG8_WAIT_V(8); PG8_WAIT_L(0); PG8_BAR; PG8_MMA(0, 0, At, B0); PG8_MMA(0, 1, At, B1); PG8_BAR; PG8_SCHED;
            PG8_LDA(At, 1, 1); PG8_STAGE(PG8_SB(1, 0), b3, voffB); PG8_STAGE(PG8_SB(1, 1), b3 + hstep, voffB); PG8_STAGE(PG8_SA(1, 0), a3, voffA);
            PG8_WAIT_V(8); PG8_WAIT_L(0); PG8_BAR; PG8_MMA(1, 0, At, B0); PG8_MMA(1, 1, At, B1); PG8_BAR; PG8_SCHED;
            } else {
            PG8_LDB(B0, 0, 0); PG8_SCHED; PG8_LDA(At, 0, 0); PG8_STAGE(PG8_SA(1, 1), a1 + hstep, voffA);
            PG8_WAIT_L(8); PG8_BAR; PG8_WAIT_L(0); PG8_MMA(0, 0, At, B0); PG8_BAR; PG8_SCHED;
            PG8_LDB(B1, 0, 1); PG8_STAGE(PG8_SB(0, 0), b2, voffB);
            PG8_BAR; PG8_WAIT_L(0); PG8_MMA(0, 1, At, B1); PG8_BAR;
            PG8_LDA(At, 0, 1); PG8_STAGE(PG8_SA(0, 0), a2, voffA);
            PG8_BAR; PG8_WAIT_L(0); PG8_MMA(1, 0, At, B0); PG8_BAR; PG8_SCHED;
            PG8_STAGE(PG8_SB(0, 1), b2 + hstep, voffB);
            PG8_WAIT_V(6); PG8_BAR; PG8_MMA(1, 1, At, B1); PG8_BAR;
            PG8_LDB(B0, 1, 0); PG8_SCHED; PG8_LDA(At, 1, 0); PG8_STAGE(PG8_SA(0, 1), a2 + hstep, voffA);
            PG8_WAIT_L(8); PG8_BAR; PG8_WAIT_L(0); PG8_MMA(0, 0, At, B0); PG8_BAR; PG8_SCHED;
            PG8_LDB(B1, 1, 1); PG8_STAGE(PG8_SB(1, 0), b3, voffB);
            PG8_BAR; PG8_WAIT_L(0); PG8_MMA(0, 1, At, B1); PG8_BAR;
            PG8_LDA(At, 1, 1); PG8_STAGE(PG8_SA(1, 0), a3, voffA);
            PG8_BAR; PG8_WAIT_L(0); PG8_MMA(1, 0, At, B0); PG8_BAR; PG8_SCHED;
            PG8_STAGE(PG8_SB(1, 1), b3 + hstep, voffB);
            PG8_WAIT_V(6); PG8_BAR; PG8_MMA(1, 1, At, B1); PG8_BAR;
            }
        }
        if constexpr (ALIGN_EPI) { if (wr == 0) PG8_BAR; }
        if constexpr (!Epi::AFTER_DRAIN) { E(acc, cur, wr, wc, fr, fq); S.done(cur); }
        if (!has_next) break;
#pragma unroll
        for (int a = 0; a < 2; ++a)
#pragma unroll
            for (int b = 0; b < 2; ++b)
#pragma unroll
                for (int m = 0; m < 4; ++m)
#pragma unroll
                    for (int n = 0; n < 2; ++n) acc[a][b][m][n] = (f32x4){0.f, 0.f, 0.f, 0.f};
        cur = nxt; cA = nA; cB = nB; ++ui;
        if constexpr (ALIGN_EPI) { if (wr == 1) PG8_BAR; }
    }
    PG8_WAIT_V(0);
    if constexpr (!ALIGN_EPI) { if (wr == 0) PG8_BAR; }
    PG8_BAR;
    if constexpr (Epi::AFTER_DRAIN) { E.fused(acc, cur, wr, wc, fr, fq, lds, wid, lane); S.done(cur); }
#undef PG8_SA
#undef PG8_SB
#undef PG8_STAGE
#undef PG8_LDA
#undef PG8_LDB
#undef PG8_MMA
#undef PG8_WAIT_V
#undef PG8_WAIT_L
#undef PG8_BAR
#undef PG8_SCHED
}
}
namespace att {
typedef unsigned short bf16_t;
typedef short bf16x8 __attribute__((ext_vector_type(8)));
typedef short s16x4 __attribute__((ext_vector_type(4)));
typedef float f32x16 __attribute__((ext_vector_type(16)));
typedef float f32x4 __attribute__((ext_vector_type(4)));
typedef unsigned u32x4 __attribute__((ext_vector_type(4)));
constexpr int NW = 8, QBLK = 32, KVBLK = 64, QB = NW * QBLK;
constexpr int SHM_V = KVBLK * 128 * 2, SHM_K = KVBLK * 128 * 2, SHM_K2 = KVBLK * 64 * 2;
constexpr int OFF_V = 0, OFF_K = 2 * SHM_V, OFF_K2 = OFF_K + 2 * SHM_K, OFF_WS = OFF_K2 + 2 * SHM_K2, OFF_Q2 = OFF_WS + NW * 64 * 4, LDS_BYTES = OFF_Q2 + NW * 4096;
constexpr float THR2 = 8.f * 1.4426950408889634f;
#define KSWZ(row, colB) ((row) * 256 + ((colB) ^ (((row) & 7) << 4)))
#define K2SWZ(row, colB) ((row) * 128 + ((colB) ^ ((((row) >> 1) & 7) << 4)))
#define SBAR() __builtin_amdgcn_sched_barrier(0)
__device__ __forceinline__ int v_st(int k, int c) { const int kk = (k & ~0xC) | ((k & 4) << 1) | ((k & 8) >> 1); return ((kk >> 3) * 4 + (c >> 5)) * 512 + ((kk & 7) * 32 + (c & 31)) * 2; }
__device__ __forceinline__ int v_rd_base(int lane) { return ((lane & 3) << 3) | (((lane >> 2) & 3) << 6) | (((lane >> 4) & 1) << 5) | (((lane >> 5) & 1) << 8); }
constexpr int v_rd_off(int d0, int ks, int half) { return d0 * 512 + ks * 4096 + half * 2048; }
__device__ __forceinline__ int crow(int r, int hi) { return (r & 3) + 8 * (r >> 2) + 4 * hi; }
__device__ __forceinline__ unsigned cvtpk(float lo, float hi) { unsigned r; asm volatile("v_cvt_pk_bf16_f32 %0, %1, %2" : "=v"(r) : "v"(lo), "v"(hi)); return r; }

template <bool NAT>
__device__ __forceinline__ void partialSM(f32x16& p0, f32x16& p1, float& m_reg, float& mn, float& alpha) {
    float pmax = p0[0]; for (int r = 1; r < 16; ++r) pmax = fmaxf(pmax, p0[r]); for (int r = 0; r < 16; ++r) pmax = fmaxf(pmax, p1[r]);
    { auto rr = __builtin_amdgcn_permlane32_swap(__float_as_uint(pmax), __float_as_uint(pmax), false, false);
      pmax = fmaxf(__uint_as_float(rr[0]), __uint_as_float(rr[1])); }
    constexpr float C2 = 1.4426950408889634f;
    if constexpr (NAT) {
        if (__builtin_expect(__all((pmax - m_reg) <= 8.f), 1)) { mn = m_reg; alpha = 1.f; }
        else { mn = fmaxf(m_reg, pmax); alpha = __builtin_amdgcn_exp2f((m_reg - mn) * C2); m_reg = mn; }
        const float mnL = -mn * C2;
        for (int r = 0; r < 16; ++r) p0[r] = fmaf(p0[r], C2, mnL); for (int r = 0; r < 16; ++r) p1[r] = fmaf(p1[r], C2, mnL);
    } else {
        if (__builtin_expect(__all((pmax - m_reg) <= THR2), 1)) { mn = m_reg; alpha = 1.f; }
        else { mn = fmaxf(m_reg, pmax); alpha = __builtin_amdgcn_exp2f(m_reg - mn); m_reg = mn; }
        for (int r = 0; r < 16; ++r) p0[r] = p0[r] - mn; for (int r = 0; r < 16; ++r) p1[r] = p1[r] - mn;
    }
    for (int r = 0; r < 16; ++r) p0[r] = __builtin_amdgcn_exp2f(p0[r]);
}
__device__ __forceinline__ void finishSM(f32x16& p0, f32x16& p1, float alpha, float& l_reg, bf16x8& pa0, bf16x8& pa1, bf16x8& pa2, bf16x8& pa3) {
    for (int r = 0; r < 16; ++r) p1[r] = __builtin_amdgcn_exp2f(p1[r]);
    float ps = 0; for (int r = 0; r < 16; ++r) ps += p0[r]; for (int r = 0; r < 16; ++r) ps += p1[r];
    { auto rr = __builtin_amdgcn_permlane32_swap(__float_as_uint(ps), __float_as_uint(ps), false, false);
      ps = __uint_as_float(rr[0]) + __uint_as_float(rr[1]); }
    l_reg = l_reg * alpha + ps;
#define PK4(P, B_, OUT) do { unsigned a0 = cvtpk(P[B_+0], P[B_+1]), a1 = cvtpk(P[B_+2], P[B_+3]);                          \
        unsigned b0 = cvtpk(P[B_+4], P[B_+5]), b1 = cvtpk(P[B_+6], P[B_+7]);                                             \
        auto r0 = __builtin_amdgcn_permlane32_swap(a0, b0, false, false); auto r1 = __builtin_amdgcn_permlane32_swap(a1, b1, false, false); \
        u32x4 w = {r0[0], r1[0], r0[1], r1[1]}; OUT = *reinterpret_cast<bf16x8*>(&w); } while (0)
    PK4(p0, 0, pa0); PK4(p0, 8, pa1); PK4(p1, 0, pa2); PK4(p1, 8, pa3);
#undef PK4
}
template <int KB, bool ROPE, bool AUG, bool QLDS = false>
__device__ __forceinline__ void qkt(f32x16& p0, f32x16& p1, const char* K_lds, const char* K2_lds, int r32, int hi, const bf16x8* qr, const char* q2l, bf16x8 ka0, bf16x8 ka1, bf16x8 qa) {
    p0 = f32x16{}; p1 = f32x16{};
    const char* kb[4];
#pragma unroll
    for (int dd = 0; dd < 4; ++dd) kb[dd] = K_lds + KB * SHM_K + KSWZ(r32, (dd * 16 + hi * 8) * 2);
#pragma unroll
    for (int d0 = 0; d0 < 8; ++d0) { const char* a = kb[d0 & 3] + (d0 >> 2) * 128;
        bf16x8 b0 = *reinterpret_cast<const bf16x8*>(a);
        bf16x8 b1 = *reinterpret_cast<const bf16x8*>(a + 32 * 256);
        bf16x8 qf; if (QLDS && d0 >= 6) qf = *reinterpret_cast<const bf16x8*>(q2l + (d0 - 6) * 1024); else qf = qr[d0];
        p0 = __builtin_amdgcn_mfma_f32_32x32x16_bf16(b0, qf, p0, 0, 0, 0);
        p1 = __builtin_amdgcn_mfma_f32_32x32x16_bf16(b1, qf, p1, 0, 0, 0); }
    if constexpr (ROPE) {
#pragma unroll
        for (int e = 0; e < 4; ++e) { const char* a = K2_lds + KB * SHM_K2 + K2SWZ(r32, (e * 2 + hi) * 16);
            bf16x8 b0 = *reinterpret_cast<const bf16x8*>(a);
            bf16x8 b1 = *reinterpret_cast<const bf16x8*>(a + 32 * 128);
            const bf16x8 q2 = *reinterpret_cast<const bf16x8*>(q2l + e * 1024);
            p0 = __builtin_amdgcn_mfma_f32_32x32x16_bf16(b0, q2, p0, 0, 0, 0);
            p1 = __builtin_amdgcn_mfma_f32_32x32x16_bf16(b1, q2, p1, 0, 0, 0); }
    }
    if constexpr (AUG) {
        p0 = __builtin_amdgcn_mfma_f32_32x32x16_bf16(ka0, qa, p0, 0, 0, 0);
        p1 = __builtin_amdgcn_mfma_f32_32x32x16_bf16(ka1, qa, p1, 0, 0, 0); }
}
template <int VB>
__device__ __forceinline__ void pv_tile(f32x16* o, int vb0, bf16x8 pa0, bf16x8 pa1, bf16x8 pa2, bf16x8 pa3) {
#define TRRD(dst, off) asm volatile("ds_read_b64_tr_b16 %0, %1 offset:%2" : "=&v"(dst) : "v"(vb0), "i"(off) : "memory")
#define PV_D0(d0) do { s16x4 l0, l1, l2, l3, h0, h1, h2, h3; constexpr int b_ = VB * SHM_V + v_rd_off(d0, 0, 0); \
        TRRD(l0, b_); TRRD(h0, b_ + 2048); TRRD(l1, b_ + 4096); TRRD(h1, b_ + 6144); TRRD(l2, b_ + 8192); TRRD(h2, b_ + 10240); TRRD(l3, b_ + 12288); TRRD(h3, b_ + 14336); \
        asm volatile("s_waitcnt lgkmcnt(0)" ::: "memory"); SBAR();   \
        o[d0] = __builtin_amdgcn_mfma_f32_32x32x16_bf16(pa0, (bf16x8){l0[0], l0[1], l0[2], l0[3], h0[0], h0[1], h0[2], h0[3]}, o[d0], 0, 0, 0);   \
        o[d0] = __builtin_amdgcn_mfma_f32_32x32x16_bf16(pa1, (bf16x8){l1[0], l1[1], l1[2], l1[3], h1[0], h1[1], h1[2], h1[3]}, o[d0], 0, 0, 0);   \
        o[d0] = __builtin_amdgcn_mfma_f32_32x32x16_bf16(pa2, (bf16x8){l2[0], l2[1], l2[2], l2[3], h2[0], h2[1], h2[2], h2[3]}, o[d0], 0, 0, 0);   \
        o[d0] = __builtin_amdgcn_mfma_f32_32x32x16_bf16(pa3, (bf16x8){l3[0], l3[1], l3[2], l3[3], h3[0], h3[1], h3[2], h3[3]}, o[d0], 0, 0, 0); } while (0)
    PV_D0(0); PV_D0(1); PV_D0(2); PV_D0(3);
#undef PV_D0
#undef TRRD
}
struct Unit {
    const bf16_t* Q;
    const bf16_t* Q2;
    const bf16_t* Kr; const bf16_t* Km;
    const bf16_t* K2r; const bf16_t* K2m;
    const bf16_t* Vr; const bf16_t* Vm;
    bf16_t* O;
    int qb; float nslope2;
    const float* kn2; const float* qst;
};
template <bool ROPE, bool ALIBI, int QP, int Q2P, int KP, int VP, int OP>
__device__ __forceinline__ void attn_unit(const Unit& u, char* lds, const int wid) {
    int lane; asm volatile("v_mbcnt_lo_u32_b32 %0, -1, 0\n\tv_mbcnt_hi_u32_b32 %0, -1, %0" : "=v"(lane));
    const int tid = wid * 64 + lane, r32 = lane & 31, hi = lane >> 5;
    int toff = 0;
    if constexpr (ALIBI) {
        const float* qs = u.qst + (4 * u.qb) * 2;
        const float qn2 = fmaxf(fmaxf(qs[0], qs[2]), fmaxf(qs[4], qs[6])), mlb = fminf(fminf(qs[1], qs[3]), fminf(qs[5], qs[7]));
        const int t = lane + 1, dmin = 256 * u.qb - 64 * t + 1;
        const bool inr = t < 4 * u.qb + 5 && dmin > 0;
        const float kn2v = inr ? u.kn2[t] : 0.f;
        const float ub = sqrtf(qn2 * kn2v) * 1.001f + 0.01f + u.nslope2 * (float)dmin;
        const unsigned long long bal = __ballot(inr && ub < mlb - 115.f);
        const int t_lo = 1 + __builtin_ctzll(~bal);
        toff = __builtin_amdgcn_readfirstlane((t_lo - 1) & ~1);
    }
    const int NT = 4 * u.qb + 5 - toff;
    const int jq = 1 + 4 * u.qb + (wid >> 1);
    char* V_lds = lds + OFF_V; char* K_lds = lds + OFF_K; char* K2_lds = lds + OFF_K2;
    float* ws = (float*)(lds + OFF_WS) + wid * 64; float* li_l = ws, * al_l = ws + 32;
    float m_reg = -1e30f, l_reg = 0; f32x16 o[4] = {};
    const int sr = tid >> 4, sc = (tid & 15) * 8, vst0 = v_st(sr, sc), vst1 = v_st(32 + sr, sc), kws = KSWZ(sr, sc * 2);
    const int sr2 = tid >> 3, sc2 = (tid & 7) * 8, k2ws = K2SWZ(sr2, sc2 * 2);
    const int vb0 = (int)(uintptr_t)V_lds + v_rd_base(lane);
    const unsigned vo0 = (unsigned)(sr * VP + sc) * 2u, vo1 = (unsigned)((32 + sr) * VP + sc) * 2u, ko0 = (unsigned)(sr * KP + sc) * 2u, ko1 = (unsigned)((32 + sr) * KP + sc) * 2u, k2o = (unsigned)(sr2 * 64 + sc2) * 2u;
    bf16x8 st_v0, st_v1, st_k0, st_k1, st_k2;
    bf16x8 qr[8]; const char* q2l = lds + OFF_Q2 + wid * 4096 + lane * 16;
#pragma unroll
    for (int d0 = 0; d0 < 8; ++d0) { const bf16x8 qv = *(const bf16x8*)(u.Q + (size_t)(wid * QBLK + r32) * QP + d0 * 16 + hi * 8);
        if (ALIBI && d0 >= 6) *(bf16x8*)(lds + OFF_Q2 + wid * 4096 + lane * 16 + (d0 - 6) * 1024) = qv; else qr[d0] = qv; }
    if constexpr (ROPE) {
#pragma unroll
        for (int e = 0; e < 4; ++e) *(bf16x8*)(lds + OFF_Q2 + wid * 4096 + lane * 16 + e * 1024) = *(const bf16x8*)(u.Q2 + (size_t)(wid * QBLK + r32) * Q2P + e * 16 + hi * 8);
    }
#define KT(t) ((t) == 0 ? u.Km : u.Kr + (size_t)(64 * ((t) + toff - 1)) * KP)
#define VT(t) ((t) == 0 ? u.Vm : u.Vr + (size_t)(64 * ((t) + toff - 1)) * VP)
#define K2T(t) ((t) == 0 ? u.K2m : u.K2r + (size_t)(64 * ((t) + toff - 1)) * 64)
#define VMW() asm volatile("s_waitcnt vmcnt(0)" ::: "memory")
#define SLOAD(t) do { const char* kt_ = (const char*)(KT(t)); const char* vt_ = (const char*)(VT(t));                         \
        st_v0 = *(const bf16x8*)(vt_ + vo0); st_v1 = *(const bf16x8*)(vt_ + vo1);                                               \
        st_k0 = *(const bf16x8*)(kt_ + ko0); st_k1 = *(const bf16x8*)(kt_ + ko1);                                               \
        if constexpr (ROPE) { st_k2 = *(const bf16x8*)((const char*)(K2T(t)) + k2o); } } while (0)
#define SWRITE_K(bf) do { *(bf16x8*)(K_lds + (bf) * SHM_K + kws) = st_k0; *(bf16x8*)(K_lds + (bf) * SHM_K + kws + 32 * 256) = st_k1;  \
        if constexpr (ROPE) { *(bf16x8*)(K2_lds + (bf) * SHM_K2 + k2ws) = st_k2; } } while (0)
#define SWRITE_V(bf) do { *(bf16x8*)(V_lds + (bf) * SHM_V + vst0) = st_v0; *(bf16x8*)(V_lds + (bf) * SHM_V + vst1) = st_v1; } while (0)
#define SWRITE(bf) do { SWRITE_V(bf); SWRITE_K(bf); } while (0)
#define RESC(a) do { if (__any((a) < 1.f)) { if (hi == 0) al_l[r32] = (a); asm volatile("s_waitcnt lgkmcnt(0)" ::: "memory");              \
                     for (int d_ = 0; d_ < 4; ++d_) for (int r = 0; r < 16; ++r) o[d_][r] *= al_l[crow(r, hi)]; } } while (0)
#define ACT(t) ((t) + toff <= jq)
    bf16x8 qa = {0, 0, 0, 0, 0, 0, 0, 0}; float n2s = 0.f;
    if constexpr (ALIBI) { const float sl = -u.nslope2;
        if (hi == 0) { const unsigned w0 = (__float_as_uint(64.f * sl) >> 16) | (__float_as_uint(sl) & 0xffff0000u), w1 = __float_as_uint(16.f * sl) >> 16;
            const u32x4 qw = {w0, w1, 0u, 0u}; qa = __builtin_bit_cast(bf16x8, qw);
            }
        n2s = -2.f * sl; }
#define KAUG(t, KA0, KA1) bf16x8 KA0 = {0, 0, 0, 0, 0, 0, 0, 0}, KA1 = KA0; if constexpr (ALIBI) { const int J_ = (t) == 0 ? -4 * u.qb : (t) + toff - 1 - 4 * u.qb;      \
        const unsigned jb_ = hi == 0 ? (__float_as_uint((float)J_) >> 16) : 0u, e3_ = (hi == 0 && (t) == 0) ? 0xbf80u : 0u;                                   \
        const unsigned cw0_ = hi == 0 ? (__float_as_uint((float)r32) & 0xffff0000u) : 0u, cw1_ = hi == 0 ? (__float_as_uint((float)(r32 + 32)) & 0xffff0000u) : 0u; \
        const u32x4 k0_ = {jb_ | cw0_, e3_, 0u, 0u}, k1_ = {jb_ | cw1_, e3_, 0u, 0u}; KA0 = __builtin_bit_cast(bf16x8, k0_); KA1 = __builtin_bit_cast(bf16x8, k1_); }
#define BIAS(P0_, P1_, t) do { if (!ACT(t)) { const float NEG_ = -__builtin_inff(); _Pragma("unroll") for (int r = 0; r < 16; ++r) { P0_[r] = NEG_; P1_[r] = NEG_; } }  \
      else if constexpr (ALIBI) { if ((t) + toff == jq) { float dqc = (float)(32 * (wid & 1) + r32 - 4 * hi); asm volatile("" : "+v"(dqc));                                                 \
        _Pragma("unroll") for (int r = 0; r < 16; ++r) { const float c_ = (float)((r & 3) + 8 * (r >> 2));                                                      \
            P0_[r] = fmaf(n2s, fmaxf(c_ - dqc, 0.f), P0_[r]); P1_[r] = fmaf(n2s, fmaxf(c_ + 32.f - dqc, 0.f), P1_[r]); } } } } while (0)
    f32x16 pA0, pA1, pB0, pB1; float mnA, mnB, alA, alB; bf16x8 pa0, pa1, pa2, pa3;
    SLOAD(0); VMW(); SWRITE(0); SBAR();
    SLOAD(1);
    __syncthreads();
    SBAR(); { KAUG(0, ka0_, ka1_); qkt<0, ROPE, ALIBI, ALIBI>(pA0, pA1, K_lds, K2_lds, r32, hi, qr, q2l, ka0_, ka1_, qa); }
    { const float NEG = -__builtin_inff();
#pragma unroll
      for (int r = 8; r < 16; ++r) pA0[r] = NEG;
#pragma unroll
      for (int r = 0; r < 16; ++r) pA1[r] = NEG; }
    BIAS(pA0, pA1, 0); partialSM<ALIBI>(pA0, pA1, m_reg, mnA, alA);
    VMW(); SWRITE(1);
    __syncthreads();
#define HALF_STEP(PX0, PX1, mnX, alX, PY0, PY1, alY, t, KB, VB, SB) do {                                                      \
        SBAR(); { KAUG(t, ka0_, ka1_); qkt<KB, ROPE, ALIBI, ALIBI>(PX0, PX1, K_lds, K2_lds, r32, hi, qr, q2l, ka0_, ka1_, qa); }             \
        finishSM(PY0, PY1, alY, l_reg, pa0, pa1, pa2, pa3); SBAR();                                                           \
        if ((t) + 1 < NT) { SLOAD((t) + 1); SBAR(); }                                                                         \
        pv_tile<VB>(o, vb0, pa0, pa1, pa2, pa3); BIAS(PX0, PX1, (t)); partialSM<ALIBI>(PX0, PX1, m_reg, mnX, alX);    \
        __syncthreads();                                                                                                      \
        if ((t) + 1 < NT) { VMW(); SWRITE(SB); }                                                                              \
        RESC(alX); __syncthreads(); } while (0)
    for (int t = 1; t + 1 < NT; t += 2) {
        HALF_STEP(pB0, pB1, mnB, alB, pA0, pA1, alA, t, 1, 0, 0);
        HALF_STEP(pA0, pA1, mnA, alA, pB0, pB1, alB, t + 1, 0, 1, 1);
    }
    finishSM(pA0, pA1, alA, l_reg, pa0, pa1, pa2, pa3); SBAR();
    pv_tile<0>(o, vb0, pa0, pa1, pa2, pa3);
    int lane2; asm volatile("v_mbcnt_lo_u32_b32 %0, -1, 0\n\tv_mbcnt_hi_u32_b32 %0, -1, %0" : "=v"(lane2));
    const int r32e = lane2 & 31, hie = lane2 >> 5;
    if (hie == 0) li_l[r32e] = l_reg; asm volatile("s_waitcnt lgkmcnt(0)" ::: "memory");
    float rli[16];
#pragma unroll
    for (int r = 0; r < 16; ++r) rli[r] = __builtin_amdgcn_rcpf(li_l[crow(r, hie)]);
    bf16_t* Ow = u.O + (size_t)(wid * QBLK) * OP;
#pragma unroll
    for (int r = 0; r < 16; ++r) { const int orow = crow(r, hie);
#pragma unroll
        for (int d0 = 0; d0 < 4; ++d0) { const float v = o[d0][r] * rli[r]; const float vn = __shfl_xor(v, 1);
            if ((r32e & 1) == 0) *(unsigned*)(Ow + (size_t)orow * OP + d0 * 32 + r32e) = cvtpk(v, vn); } }
    __syncthreads();
#undef KT
#undef VT
#undef K2T
#undef VMW
#undef SLOAD
#undef SWRITE_K
#undef SWRITE_V
#undef SWRITE
#undef RESC
#undef ACT
#undef BIAS
#undef KAUG
#undef HALF_STEP
}
typedef __attribute__((address_space(1))) const char* gcptr;
__device__ __forceinline__ gcptr sgpr_ptr(const char* p) {
    const unsigned long long v = (unsigned long long)p; const unsigned lo = (unsigned)__builtin_amdgcn_readfirstlane((int)(unsigned)v), hi = (unsigned)__builtin_amdgcn_readfirstlane((int)(unsigned)(v >> 32));
    return (gcptr)(((unsigned long long)hi << 32) | lo); }
struct UnitX {
    const bf16_t* Q;
    const bf16_t* Kr; const bf16_t* Km;
    const bf16_t* V0r; const bf16_t* V0m; const bf16_t* V1r; const bf16_t* V1m;
    bf16_t* O;
    int qb; float nslope;
    const float* kn2; const float* qst;
};
constexpr int XOFF_V = 0, XOFF_K = 65536, XOFF_P = 98304, XOFF_WS = 131072, XOFF_PS = XOFF_WS + 2048, XLDS_BYTES = XOFF_PS + 2048;
template <int OP>
__device__ __forceinline__ void attn_unit_x(const UnitX& u, char* lds, const int wid) {
    int lane; asm volatile("v_mbcnt_lo_u32_b32 %0, -1, 0\n\tv_mbcnt_hi_u32_b32 %0, -1, %0" : "=v"(lane));
    const int tid = wid * 64 + lane, r32 = lane & 31, hi = lane >> 5, g = wid & 3, vh = wid >> 2;
    int toff = 0;
    { const float* qs = u.qst + (2 * u.qb) * 2;
      const float qn2 = fmaxf(qs[0], qs[2]), mlb = fminf(qs[1], qs[3]);
      const int t = lane + 1, dmin = 128 * u.qb - 64 * t + 1;
      const bool inr = t < 2 * u.qb + 3 && dmin > 0;
      const float kn2v = inr ? u.kn2[t] : 0.f;
      float k1_ = 1.001f, k2_ = 115.01f; asm volatile("" : "+v"(k1_), "+v"(k2_));
      const float ub = sqrtf(qn2 * kn2v) * k1_ + u.nslope * (float)dmin;
      const unsigned long long bal = __ballot(inr && ub < mlb - k2_);
      const int t_lo = 1 + __builtin_ctzll(~bal);
      toff = __builtin_amdgcn_readfirstlane((t_lo - 1) & ~1); }
    const int NT = 2 * u.qb + 3 - toff;
    const int jq = 1 + 2 * u.qb + (g >> 1);
    char* K_lds = lds + XOFF_K; char* Vh_lds = lds + XOFF_V + vh * 32768;
    char* pbuf = lds + XOFF_P + g * 8192 + lane * 16;
    float* psc = (float*)(lds + XOFF_PS) + g * 128;
    float l_reg = 0.f; f32x16 o[4] = {};
    const int sr = tid >> 4, sc = (tid & 15) * 8, vst0 = v_st(sr, sc), vst1 = v_st(32 + sr, sc), kws = KSWZ(sr, sc * 2);
    const int vb0 = (int)(uintptr_t)Vh_lds + v_rd_base(lane);
    const unsigned so0 = (unsigned)(sr * 128 + sc) * 2u, so1 = (unsigned)((32 + sr) * 128 + sc) * 2u;
    bf16x8 st_k0, st_k1, st_a0, st_a1, st_b0, st_b1;
    bf16x8 qr[8];
#pragma unroll
    for (int d0 = 0; d0 < 8; ++d0) qr[d0] = *(const bf16x8*)(u.Q + (size_t)(g * QBLK + r32) * 128 + d0 * 16 + hi * 8);
    unsigned qw0s, qw1s; float n2s;
    { const float sl = -u.nslope;
      qw0s = (unsigned)__builtin_amdgcn_readfirstlane((int)((__float_as_uint(64.f * sl) >> 16) | (__float_as_uint(sl) & 0xffff0000u)));
      qw1s = (unsigned)__builtin_amdgcn_readfirstlane((int)(__float_as_uint(16.f * sl) >> 16)); n2s = -2.f * sl; }
#define XKT(t) ((const char*)((t) == 0 ? u.Km : u.Kr + (size_t)(64 * ((t) + toff - 1)) * 128))
#define XV0T(t) ((const char*)((t) == 0 ? u.V0m : u.V0r + (size_t)(64 * ((t) + toff - 1)) * 128))
#define XV1T(t) ((const char*)((t) == 0 ? u.V1m : u.V1r + (size_t)(64 * ((t) + toff - 1)) * 128))
#define XVMW() asm volatile("s_waitcnt vmcnt(0)" ::: "memory")
#define XLOAD_K(t) do { const gcptr p_ = sgpr_ptr(XKT(t)); st_k0 = *(const __attribute__((address_space(1))) bf16x8*)(p_ + so0); st_k1 = *(const __attribute__((address_space(1))) bf16x8*)(p_ + so1); } while (0)
#define XLOAD_V(t) do { const gcptr a_ = sgpr_ptr(XV0T(t)); const gcptr b_ = sgpr_ptr(XV1T(t)); st_a0 = *(const __attribute__((address_space(1))) bf16x8*)(a_ + so0); st_a1 = *(const __attribute__((address_space(1))) bf16x8*)(a_ + so1); st_b0 = *(const __attribute__((address_space(1))) bf16x8*)(b_ + so0); st_b1 = *(const __attribute__((address_space(1))) bf16x8*)(b_ + so1); } while (0)
#define XWRITE_K(bf) do { *(bf16x8*)(K_lds + (bf) * SHM_K + kws) = st_k0; *(bf16x8*)(K_lds + (bf) * SHM_K + kws + 32 * 256) = st_k1; } while (0)
#define XWRITE_V(bf) do { *(bf16x8*)(lds + XOFF_V + (bf) * SHM_V + vst0) = st_a0; *(bf16x8*)(lds + XOFF_V + (bf) * SHM_V + vst1) = st_a1;             \
        *(bf16x8*)(lds + XOFF_V + 32768 + (bf) * SHM_V + vst0) = st_b0; *(bf16x8*)(lds + XOFF_V + 32768 + (bf) * SHM_V + vst1) = st_b1; } while (0)
#define XACT(t) ((t) + toff <= jq)
#define XKAUG(t, KA0, KA1, QA) bf16x8 KA0, KA1, QA; { int hz_ = hi; asm volatile("" : "+v"(hz_));                                                       \
        const u32x4 qw_ = {hz_ == 0 ? qw0s : 0u, hz_ == 0 ? qw1s : 0u, 0u, 0u}; QA = __builtin_bit_cast(bf16x8, qw_);                                   \
        const int J_ = (t) == 0 ? -2 * u.qb : (t) + toff - 1 - 2 * u.qb;                                                                                \
        const unsigned jb_ = hz_ == 0 ? (__float_as_uint((float)J_) >> 16) : 0u, e3_ = (hz_ == 0 && (t) == 0) ? 0xbf80u : 0u;                            \
        const unsigned cw0_ = hz_ == 0 ? (__float_as_uint((float)r32) & 0xffff0000u) : 0u, cw1_ = hz_ == 0 ? (__float_as_uint((float)(r32 + 32)) & 0xffff0000u) : 0u; \
        const u32x4 k0_ = {jb_ | cw0_, e3_, 0u, 0u}, k1_ = {jb_ | cw1_, e3_, 0u, 0u}; KA0 = __builtin_bit_cast(bf16x8, k0_); KA1 = __builtin_bit_cast(bf16x8, k1_); }
#define XQKT(t, KB) do { XKAUG(t, ka0_, ka1_, qa_); qkt<KB, false, true>(S0, S1, K_lds, nullptr, r32, hi, qr, nullptr, ka0_, ka1_, qa_); } while (0)
#define XSM(t, PB) do {                                                                                                                                  \
        if ((t) == 0) { const float NEG_ = -__builtin_inff(); _Pragma("unroll") for (int r = 8; r < 16; ++r) S0[r] = NEG_; _Pragma("unroll") for (int r = 0; r < 16; ++r) S1[r] = NEG_; } \
        if (!XACT(t)) { const float NEG_ = -__builtin_inff(); _Pragma("unroll") for (int r = 0; r < 16; ++r) { S0[r] = NEG_; S1[r] = NEG_; } }           \
        else if ((t) + toff == jq) { float dqc = (float)(32 * (g & 1) + r32 - 4 * hi); asm volatile("" : "+v"(dqc));                                    \
            _Pragma("unroll") for (int r = 0; r < 16; ++r) { const float c_ = (float)((r & 3) + 8 * (r >> 2));                                           \
                S0[r] = fmaf(n2s, fmaxf(c_ - dqc, 0.f), S0[r]); S1[r] = fmaf(n2s, fmaxf(c_ + 32.f - dqc, 0.f), S1[r]); } }                                \
        float m_ = (t) == 0 ? -1e30f : psc[(1 - (PB)) * 64 + 32 + r32]; float mn_, al_;                                                                  \
        partialSM<true>(S0, S1, m_, mn_, al_); finishSM(S0, S1, al_, l_reg, pa0, pa1, pa2, pa3); alpha = al_;                                           \
        if (hi == 0) { psc[(PB) * 64 + r32] = al_; psc[(PB) * 64 + 32 + r32] = mn_; }                                                                   \
        *(bf16x8*)(pbuf + (PB) * 4096) = pa0; *(bf16x8*)(pbuf + (PB) * 4096 + 1024) = pa1; *(bf16x8*)(pbuf + (PB) * 4096 + 2048) = pa2; *(bf16x8*)(pbuf + (PB) * 4096 + 3072) = pa3; } while (0)
#define XPV(t, PB, VB, OWN) do {                                                                                                                          \
        if (!(OWN)) { alpha = psc[(PB) * 64 + r32]; l_reg *= alpha;                                                                                      \
            pa0 = *(const bf16x8*)(pbuf + (PB) * 4096); pa1 = *(const bf16x8*)(pbuf + (PB) * 4096 + 1024); pa2 = *(const bf16x8*)(pbuf + (PB) * 4096 + 2048); pa3 = *(const bf16x8*)(pbuf + (PB) * 4096 + 3072); } \
        if (__any(alpha < 1.f)) { asm volatile("s_waitcnt lgkmcnt(0)" ::: "memory");                                                                      \
            for (int d_ = 0; d_ < 4; ++d_) for (int r = 0; r < 16; ++r) o[d_][r] *= psc[(PB) * 64 + crow(r, hi)]; }                                      \
        if (XACT(t)) pv_tile<VB>(o, vb0, pa0, pa1, pa2, pa3); } while (0)
    f32x16 S0, S1; bf16x8 pa0, pa1, pa2, pa3; float alpha = 1.f;
    { XLOAD_K(1); const bf16x8 n0_ = st_k0, n1_ = st_k1;
      XLOAD_K(0); XLOAD_V(0); XVMW(); XWRITE_K(0); XWRITE_V(0);
      *(bf16x8*)(K_lds + SHM_K + kws) = n0_; *(bf16x8*)(K_lds + SHM_K + kws + 32 * 256) = n1_; }
    __syncthreads();
    if (vh == 0) XQKT(0, 0);
#define XSTEP(t, PB, KBN, VBT, LAST) do {                                                                                                                 \
        const bool own_ = (((t) & 1) == vh);                                                                                                            \
        if (!(LAST)) { if ((t) + 2 < NT) XLOAD_K((t) + 2); XLOAD_V((t) + 1); }                                                                           \
        SBAR();                                                                                                                                          \
        if (own_) { XSM(t, PB); } else if (!(LAST)) { XQKT((t) + 1, KBN); }                                                                              \
        asm volatile("s_waitcnt lgkmcnt(0)" ::: "memory"); __syncthreads();                                                                              \
        if (!(LAST)) { XVMW(); if ((t) + 2 < NT) XWRITE_K(PB); XWRITE_V(1 - (PB)); }                                                                      \
        XPV(t, PB, VBT, own_);                                                                                                                            \
        asm volatile("s_waitcnt lgkmcnt(0)" ::: "memory"); __syncthreads(); } while (0)
    int t = 0;
    for (; t + 1 < NT; t += 2) {
        XSTEP(t, 0, 1, 0, false);
        XSTEP(t + 1, 1, 0, 1, false);
    }
    XSTEP(NT - 1, 0, 1, 0, true);
    int lane2; asm volatile("v_mbcnt_lo_u32_b32 %0, -1, 0\n\tv_mbcnt_hi_u32_b32 %0, -1, %0" : "=v"(lane2));
    const int r32e = lane2 & 31, hie = lane2 >> 5;
    if (hie == 0) psc[vh * 64 + r32e] = l_reg;
    asm volatile("s_waitcnt lgkmcnt(0)" ::: "memory"); __syncthreads();
    float rli[16];
#pragma unroll
    for (int r = 0; r < 16; ++r) rli[r] = __builtin_amdgcn_rcpf(psc[crow(r, hie)] + psc[64 + crow(r, hie)]);
    bf16_t* Ow = u.O + (size_t)(g * QBLK) * OP + vh * 128;
#pragma unroll
    for (int r = 0; r < 16; ++r) { const int orow = crow(r, hie);
#pragma unroll
        for (int d0 = 0; d0 < 4; ++d0) { const float v = o[d0][r] * rli[r]; const float vn = __shfl_xor(v, 1);
            if ((r32e & 1) == 0) *(unsigned*)(Ow + (size_t)orow * OP + d0 * 32 + r32e) = cvtpk(v, vn); } }
    asm volatile("s_waitcnt lgkmcnt(0)" ::: "memory"); __syncthreads();
#undef XKT
#undef XV0T
#undef XV1T
#undef XVMW
#undef XLOAD_K
#undef XLOAD_V
#undef XWRITE_K
#undef XWRITE_V
#undef XACT
#undef XKAUG
#undef XQKT
#undef XSM
#undef XPV
#undef XSTEP
}
#undef KSWZ
#undef K2SWZ
#undef SBAR
}

constexpr int NWAVES = 8;
constexpr int D_MODEL = 4096, BATCH = 4, SEQ = 4096, N_META = 16;
constexpr int MR = BATCH * SEQ;
constexpr int MP = MR + 256;
constexpr int NIN = 12544;
constexpr int Q_LORA = 1536, KV_LORA = 512;
constexpr float RMS_EPS = 1e-6f, LOG2E = 1.4426950408889634f;
constexpr float LAMBDA_INIT = 0.2f;
constexpr size_t MiB = 1u << 20;
constexpr size_t WS_WIN = 0;
constexpr size_t WS_O1 = 0;
constexpr size_t WS_WUQ = 98 * MiB;
constexpr size_t WS_WUKV = 107 * MiB;
constexpr size_t WS_WOUT = 111 * MiB;
constexpr size_t WS_TAB = 143 * MiB;
constexpr size_t WS_XN = 145 * MiB;
constexpr size_t WS_QD = 275 * MiB, WS_KD = 340 * MiB, WS_VD = 405 * MiB, WS_GD = 470 * MiB;
constexpr size_t WS_CQ = 535 * MiB;
constexpr size_t WS_CKV = WS_CQ + (size_t)MP * Q_LORA * 2;
constexpr size_t WS_O2 = WS_CQ;
constexpr size_t WS_GM = 600 * MiB;
constexpr size_t WS_KR = 665 * MiB;
constexpr size_t WS_QN = 668 * MiB;
constexpr size_t WS_QR = 733 * MiB;
constexpr size_t WS_KV = 766 * MiB;
constexpr size_t WS_OB = 896 * MiB;
constexpr size_t WS_CTL = 961 * MiB, CTL_ZERO_BYTES = 16384;
constexpr size_t WS_END = 962 * MiB;
static_assert(WS_CKV + (size_t)MP * KV_LORA * 2 <= WS_GM && (size_t)NIN * 4096 * 2 <= WS_WUQ && WS_XN + (size_t)MP * 4096 * 2 <= WS_QD, "d_ws map");
constexpr int RING_BYTES = 135168, LDSCTL_OFF = RING_BYTES, MISC_OFF = LDSCTL_OFF + 320, LDS_BYTES = 147456;
static_assert(att::LDS_BYTES <= RING_BYTES && att::XLDS_BYTES <= RING_BYTES, "attention LDS");
#define LAS __attribute__((address_space(3)))
#define GAS __attribute__((address_space(1)))
#define RLX_AGENT __ATOMIC_RELAXED, __HIP_MEMORY_SCOPE_AGENT
typedef unsigned short bf16;
typedef unsigned v4u __attribute__((ext_vector_type(4)));
typedef float f32x4 __attribute__((ext_vector_type(4)));
#define LDS_WAIT() asm volatile("s_waitcnt lgkmcnt(0)" ::: "memory")
__device__ __forceinline__ unsigned f2bf(float f) { unsigned u = __builtin_bit_cast(unsigned, f); return (u + 0x7fffu + ((u >> 16) & 1u)) >> 16; }
__device__ __forceinline__ unsigned pk2(float lo, float hi) { return f2bf(lo) | (f2bf(hi) << 16); }
__device__ __forceinline__ float bflo(unsigned w) { return __builtin_bit_cast(float, w << 16); }
__device__ __forceinline__ float bfhi(unsigned w) { return __builtin_bit_cast(float, w & 0xffff0000u); }
__device__ __forceinline__ float wave_sum(float v) {
#pragma unroll
    for (int o = 1; o < 64; o <<= 1) v += __shfl_xor(v, o);
    return v;
}
__device__ __forceinline__ float silu(float x) { return x / (1.f + __expf(-x)); }

__device__ __forceinline__ int lane_id() { int l; asm volatile("v_mbcnt_lo_u32_b32 %0, -1, 0\n\tv_mbcnt_hi_u32_b32 %0, -1, %0" : "=v"(l)); return l; }
#define XB_TMO      128
#define XB_XCNT(j)  (256  + 64 * (j))
#define XB_XSUB(j)  (1280 + 64 * (j))
#define XB_XGEN(j)  (2304 + 64 * (j))
#define XB_TOP      3328
#define XB_TOPGEN   3392
#define XCD_BAR_WORDS 3456
#define XB_SPIN_CAP (1u << 18)

__device__ __forceinline__ unsigned xb_ld(unsigned* p)              { return __hip_atomic_load(p, __ATOMIC_RELAXED, __HIP_MEMORY_SCOPE_AGENT); }
__device__ __forceinline__ unsigned xb_add(unsigned* p, unsigned v) { return __hip_atomic_fetch_add(p, v, __ATOMIC_RELAXED, __HIP_MEMORY_SCOPE_AGENT); }
__device__ __forceinline__ unsigned xb_xcc_id() { return (unsigned)__builtin_amdgcn_s_getreg((3 << 11) | 20) & 0xFu; }
#define XB_SPIN(cond, bar) do { unsigned _sp = 0; while (cond) { __builtin_amdgcn_s_sleep(1); \
    if ((++_sp & 255u) == 0u) { if (xb_ld(&(bar)[XB_TMO])) break; if (_sp > XB_SPIN_CAP) { atomicAdd(&(bar)[XB_TMO], 1u); break; } } } } while (0)

struct XcdBarrier {
    unsigned* bar; unsigned x; int w;
    volatile LAS unsigned* st;
};

__device__ __forceinline__ XcdBarrier xcd_barrier_post(unsigned* bar, volatile LAS unsigned* st, int wave_) {
    XcdBarrier b; b.bar = bar; b.x = xb_xcc_id(); b.st = st; b.w = wave_;
    if (wave_ == 0 && lane_id() == 0) (void)xb_add(&bar[XB_XCNT(b.x)], 1u);
    return b;
}
__device__ __forceinline__ void xcd_barrier_complete(unsigned* bar, unsigned x, unsigned& nloc, unsigned& nx) {
    const unsigned G = gridDim.x * gridDim.y * gridDim.z;
    unsigned sum, cnt, mine, sp = 0u;
    for (;;) {
        sum = 0u; cnt = 0u; mine = 0u;
#pragma unroll
        for (unsigned j = 0; j < 16; ++j) { const unsigned c = xb_ld(&bar[XB_XCNT(j)]); sum += c; cnt += (c > 0u) ? 1u : 0u; mine = (j == x) ? c : mine; }
        if (sum == G) break;
        __builtin_amdgcn_s_sleep(1);
        if ((++sp & 255u) == 0u) { if (xb_ld(&bar[XB_TMO])) break; if (sp > XB_SPIN_CAP) { atomicAdd(&bar[XB_TMO], 1u); break; } }
    }
    nloc = mine > 0u ? mine : 1u; nx = cnt > 0u ? cnt : 1u;
}

__device__ __forceinline__ void xcd_barrier(const XcdBarrier& b) {
    asm volatile("s_waitcnt vmcnt(0)" ::: "memory");
    __syncthreads();
    if (b.w == 0 && lane_id() == 0) {
        unsigned* bar = b.bar;
        __builtin_amdgcn_s_waitcnt(0);
        unsigned nloc = b.st[0], nx = b.st[1];
        if (nloc == 0u) { xcd_barrier_complete(bar, b.x, nloc, nx); b.st[0] = nloc; b.st[1] = nx; }
        const unsigned old = xb_add(&bar[XB_XSUB(b.x)], 1u);
        const unsigned gen = old / nloc;
        if (old + 1u == (gen + 1u) * nloc) {
            __builtin_amdgcn_fence(__ATOMIC_RELEASE, "agent");
            asm volatile("s_waitcnt vmcnt(0)" ::: "memory");
            const unsigned og = xb_add(&bar[XB_TOP], 1u);
            const unsigned tg = og / nx;
            if (og + 1u == (tg + 1u) * nx) xb_add(&bar[XB_TOPGEN], 1u);
            else XB_SPIN(xb_ld(&bar[XB_TOPGEN]) == tg, bar);
            __builtin_amdgcn_fence(__ATOMIC_ACQUIRE, "agent");
            xb_add(&bar[XB_XGEN(b.x)], 1u);
            asm volatile("s_waitcnt vmcnt(0)" ::: "memory");
        } else {
            XB_SPIN(xb_ld(&bar[XB_XGEN(b.x)]) == gen, bar);
            __builtin_amdgcn_fence(__ATOMIC_ACQUIRE, "agent");
            asm volatile("s_waitcnt vmcnt(0)" ::: "memory");
        }
    }
    __syncthreads();
}

struct MapIn { __device__ __forceinline__ int operator()(int n) const {
    if (n < 10240) return n; if (n < 12288) return n + 64; if (n < 12352) { const int j = n - 12288; return 10240 + (j & 1) * 32 + (j >> 1); } return -1; } };
struct MapUq { __device__ __forceinline__ int operator()(int n) const {
    if (n < 2048) return (n >> 7) * 192 + (n & 127); const int j = n - 2048, h = j >> 6, jj = j & 63; return h * 192 + 128 + (jj & 1) * 32 + (jj >> 1); } };
struct MapId { __device__ __forceinline__ int operator()(int n) const { return n; } };
struct MapInB { __device__ __forceinline__ int operator()(int n) const { return MapIn{}(n + 12288); } };
struct MapUqB { __device__ __forceinline__ int operator()(int n) const { return MapUq{}(n + 2048); } };
template <bool GATHER, class Map>
__device__ __forceinline__ void p0_transpose_item(const float* W, int K, int Nsrc, int Nd, bf16* WT, LAS float* scr, int item, int lane, Map map) {
    const int nblk = Nd / 64, kb = item / nblk, nb = item % nblk, k0 = 64 * kb, n0 = 64 * nb;
    const int nq = 4 * (lane & 15), kr = lane >> 4;
    f32x4 v[16];
    if constexpr (GATHER) {
        const int s0 = map(n0 + nq), s1 = map(n0 + nq + 1), s2 = map(n0 + nq + 2), s3 = map(n0 + nq + 3);
#pragma unroll
        for (int i = 0; i < 16; ++i) { const float* r = W + (size_t)(k0 + 4 * i + kr) * Nsrc; v[i] = (f32x4){s0 >= 0 ? r[s0] : 0.f, s1 >= 0 ? r[s1] : 0.f, s2 >= 0 ? r[s2] : 0.f, s3 >= 0 ? r[s3] : 0.f}; }
    } else {
        const int s0 = map(n0 + nq);
#pragma unroll
        for (int i = 0; i < 16; ++i) v[i] = s0 >= 0 ? __builtin_nontemporal_load((const f32x4*)(W + (size_t)(k0 + 4 * i + kr) * Nsrc + s0)) : (f32x4){0.f, 0.f, 0.f, 0.f};
    }
#pragma unroll
    for (int i = 0; i < 16; ++i) { LAS float* d = scr + (4 * i + kr) * 65 + nq; d[0] = v[i][0]; d[1] = v[i][1]; d[2] = v[i][2]; d[3] = v[i][3]; }
    LDS_WAIT(); asm volatile("" ::: "memory");
    const int c = lane & 7;
#pragma unroll
    for (int j = 0; j < 8; ++j) { const int n = (lane >> 3) + 8 * j; const LAS float* s = scr + (8 * c) * 65 + n;
        v4u o; o.x = pk2(s[0 * 65], s[1 * 65]); o.y = pk2(s[2 * 65], s[3 * 65]); o.z = pk2(s[4 * 65], s[5 * 65]); o.w = pk2(s[6 * 65], s[7 * 65]);
        *(v4u*)(WT + (size_t)(n0 + n) * K + k0 + 8 * c) = o; }
    LDS_WAIT(); asm volatile("" ::: "memory");
}
__device__ __forceinline__ void rms_row_to_bf16(const float* xrow, const float* g, bf16* orow, int lane) {
    const f32x4* xr = (const f32x4*)xrow + lane; const f32x4* gr = (const f32x4*)g + lane;
    f32x4 v[16]; float s = 0.f;
#pragma unroll
    for (int j = 0; j < 16; ++j) { v[j] = __builtin_nontemporal_load(xr + 64 * j); s += (v[j].x * v[j].x + v[j].y * v[j].y) + (v[j].z * v[j].z + v[j].w * v[j].w); }
    const float rstd = 1.f / sqrtf(wave_sum(s) * (1.f / D_MODEL) + RMS_EPS);
    unsigned long long* o8 = (unsigned long long*)orow + lane;
#pragma unroll
    for (int j = 0; j < 16; ++j) { const f32x4 gg = gr[64 * j];
        o8[64 * j] = (unsigned long long)pk2(v[j].x * rstd * gg.x, v[j].y * rstd * gg.y) | ((unsigned long long)pk2(v[j].z * rstd * gg.z, v[j].w * rstd * gg.w) << 32); }
}

typedef short bf16x8 __attribute__((ext_vector_type(8)));
template <int RB, int NB>
__device__ __forceinline__ void mini_gemm(const bf16* A, size_t lda, const bf16* Bt, size_t ldb, int K, f32x4 (&acc)[RB][NB], int lane) {
    const bf16* ap = A + (size_t)(lane & 15) * lda + 8 * (lane >> 4); const bf16* bp = Bt + (size_t)(lane & 15) * ldb + 8 * (lane >> 4);
#pragma unroll
    for (int rb = 0; rb < RB; ++rb)
#pragma unroll
        for (int nb = 0; nb < NB; ++nb) acc[rb][nb] = (f32x4){0.f, 0.f, 0.f, 0.f};
#pragma unroll 4
    for (int k0 = 0; k0 < K; k0 += 32) { bf16x8 a[RB], b[NB];
#pragma unroll
        for (int rb = 0; rb < RB; ++rb) a[rb] = *(const bf16x8*)(ap + (size_t)rb * 16 * lda + k0);
#pragma unroll
        for (int nb = 0; nb < NB; ++nb) b[nb] = *(const bf16x8*)(bp + (size_t)nb * 16 * ldb + k0);
#pragma unroll
        for (int rb = 0; rb < RB; ++rb)
#pragma unroll
            for (int nb = 0; nb < NB; ++nb) acc[rb][nb] = __builtin_amdgcn_mfma_f32_16x16x32_bf16(a[rb], b[nb], acc[rb][nb], 0, 0, 0); }
}
template <int RB, int NB>
__device__ __forceinline__ void wg_task(const bf16* A, const bf16* Bt, LAS float* red, f32x4 (&res)[RB * NB / 4], int wave, int lane) {
    f32x4 acc[RB][NB]; mini_gemm<RB, NB>(A + 512 * wave, 4096, Bt + 512 * wave, 4096, 512, acc, lane);
#pragma unroll
    for (int r = 0; r < RB * NB / 4; ++r) {
#pragma unroll
        for (int i = 0; i < 4; ++i) *(LAS f32x4*)(red + ((wave * 4 + i) * 64 + lane) * 4) = acc[(4 * r + i) / NB][(4 * r + i) % NB];
        __syncthreads();
        f32x4 s = {0.f, 0.f, 0.f, 0.f};
        if (wave < 4) {
#pragma unroll
            for (int w = 0; w < 8; ++w) s += *(LAS f32x4*)(red + ((w * 4 + wave) * 64 + lane) * 4); }
        res[r] = s;
        __syncthreads(); }
}

__device__ const unsigned short ATT_ORDER[3072] = {
    32783,32799,32815,32831,32847,32863,32879,32895,32911,32927,32943,32959,32975,32991,33007,33023,33039,33055,33071,33087,33103,33119,33135,33151,33167,33183,33199,33215,33231,33247,33263,33279,
    33295,33311,33327,33343,33359,33375,33391,33407,33423,33439,33455,33471,33487,33503,33519,33535,33551,33567,33583,33599,33615,33631,33647,33663,33679,33695,33711,33727,33743,33759,33775,33791,
    32782,32798,32814,32830,32846,32862,32878,32894,32910,32926,32942,32958,32974,32990,33006,33022,33038,33054,33070,33086,33102,33118,33134,33150,33166,33182,33198,33214,33230,33246,33262,33278,
    33294,33310,33326,33342,33358,33374,33390,33406,33422,33438,33454,33470,33486,33502,33518,33534,33550,33566,33582,33598,33614,33630,33646,33662,33678,33694,33710,33726,33742,33758,33774,33790,
    32781,32797,32813,32829,32845,32861,32877,32893,32909,32925,32941,32957,32973,32989,33005,33021,33037,33053,33069,33085,33101,33117,33133,33149,33165,33181,33197,33213,33229,33245,33261,33277,
    33293,33309,33325,33341,33357,33373,33389,33405,33421,33437,33453,33469,33485,33501,33517,33533,33549,33565,33581,33597,33613,33629,33645,33661,33677,33693,33709,33725,33741,33757,33773,33789,
    32780,32796,32812,32828,32844,32860,32876,32892,32908,32924,32940,32956,32972,32988,33004,33020,33036,33052,33068,33084,33100,33116,33132,33148,33164,33180,33196,33212,33228,33244,33260,33276,
    33292,33308,33324,33340,33356,33372,33388,33404,33420,33436,33452,33468,33484,33500,33516,33532,33548,33564,33580,33596,33612,33628,33644,33660,33676,33692,33708,33724,33740,33756,33772,33788,
    32779,32795,32811,32827,32843,32859,32875,32891,32907,32923,32939,32955,32971,32987,33003,33019,33035,33051,33067,33083,33099,33115,33131,33147,33163,33179,33195,33211,33227,33243,33259,33275,
    33291,33307,33323,33339,33355,33371,33387,33403,33419,33435,33451,33467,33483,33499,33515,33531,33547,33563,33579,33595,33611,33627,33643,33659,33675,33691,33707,33723,33739,33755,33771,33787,
    32778,32794,32810,32826,32842,32858,32874,32890,32906,32922,32938,32954,32970,32986,33002,33018,33034,33050,33066,33082,33098,33114,33130,33146,33162,33178,33194,33210,33226,33242,33258,33274,
    33290,33306,33322,33338,33354,33370,33386,33402,33418,33434,33450,33466,33482,33498,33514,33530,33546,33562,33578,33594,33610,33626,33642,33658,33674,33690,33706,33722,33738,33754,33770,33786,
    32777,32793,32809,32825,32841,32857,32873,32889,32905,32921,32937,32953,32969,32985,33001,33017,33033,33049,33065,33081,33097,33113,33129,33145,33161,33177,33193,33209,33225,33241,33257,33273,
    33289,33305,33321,33337,33353,33369,33385,33401,33417,33433,33449,33465,33481,33497,33513,33529,33545,33561,33577,33593,33609,33625,33641,33657,33673,33689,33705,33721,33737,33753,33769,33785,
    287,319,351,383,415,447,479,511,799,831,863,895,927,959,991,1023,1311,1343,1375,1407,1439,1471,1503,1535,1823,1855,1887,1919,1951,1983,2015,2047,
    286,318,350,382,414,446,478,510,798,830,862,894,926,958,990,1022,1310,1342,1374,1406,1438,1470,1502,1534,1822,1854,1886,1918,1950,1982,2014,2046,
    285,317,349,381,413,445,477,509,797,829,861,893,925,957,989,1021,1309,1341,1373,1405,1437,1469,1501,1533,1821,1853,1885,1917,1949,1981,2013,2045,
    32776,32792,32808,32824,32840,32856,32872,32888,32904,32920,32936,32952,32968,32984,33000,33016,33032,33048,33064,33080,33096,33112,33128,33144,33160,33176,33192,33208,33224,33240,33256,33272,
    33288,33304,33320,33336,33352,33368,33384,33400,33416,33432,33448,33464,33480,33496,33512,33528,33544,33560,33576,33592,33608,33624,33640,33656,33672,33688,33704,33720,33736,33752,33768,33784,
    284,316,348,380,412,444,476,508,796,828,860,892,924,956,988,1020,1308,1340,1372,1404,1436,1468,1500,1532,1820,1852,1884,1916,1948,1980,2012,2044,
    283,315,347,379,411,443,475,507,795,827,859,891,923,955,987,1019,1307,1339,1371,1403,1435,1467,1499,1531,1819,1851,1883,1915,1947,1979,2011,2043,
    282,314,346,378,410,442,474,506,794,826,858,890,922,954,986,1018,1306,1338,1370,1402,1434,1466,1498,1530,1818,1850,1882,1914,1946,1978,2010,2042,
    32775,32791,32807,32823,32839,32855,32871,32887,32903,32919,32935,32951,32967,32983,32999,33015,33031,33047,33063,33079,33095,33111,33127,33143,33159,33175,33191,33207,33223,33239,33255,33271,
    33287,33303,33319,33335,33351,33367,33383,33399,33415,33431,33447,33463,33479,33495,33511,33527,33543,33559,33575,33591,33607,33623,33639,33655,33671,33687,33703,33719,33735,33751,33767,33783,
    281,313,345,377,409,441,473,505,793,825,857,889,921,953,985,1017,1305,1337,1369,1401,1433,1465,1497,1529,1817,1849,1881,1913,1945,1977,2009,2041,
    280,312,344,376,408,440,472,504,792,824,856,888,920,952,984,1016,1304,1336,1368,1400,1432,1464,1496,1528,1816,1848,1880,1912,1944,1976,2008,2040,
    279,311,343,375,407,439,471,503,791,823,855,887,919,951,983,1015,1303,1335,1367,1399,1431,1463,1495,1527,1815,1847,1879,1911,1943,1975,2007,2039,
    278,310,342,374,406,438,470,502,790,822,854,886,918,950,982,1014,1302,1334,1366,1398,1430,1462,1494,1526,1814,1846,1878,1910,1942,1974,2006,2038,
    32774,32790,32806,32822,32838,32854,32870,32886,32902,32918,32934,32950,32966,32982,32998,33014,33030,33046,33062,33078,33094,33110,33126,33142,33158,33174,33190,33206,33222,33238,33254,33270,
    33286,33302,33318,33334,33350,33366,33382,33398,33414,33430,33446,33462,33478,33494,33510,33526,33542,33558,33574,33590,33606,33622,33638,33654,33670,33686,33702,33718,33734,33750,33766,33782,
    277,309,341,373,405,437,469,501,789,821,853,885,917,949,981,1013,1301,1333,1365,1397,1429,1461,1493,1525,1813,1845,1877,1909,1941,1973,2005,2037,
    276,308,340,372,404,436,468,500,788,820,852,884,916,948,980,1012,1300,1332,1364,1396,1428,1460,1492,1524,1812,1844,1876,1908,1940,1972,2004,2036,
    275,307,339,371,403,435,467,499,787,819,851,883,915,947,979,1011,1299,1331,1363,1395,1427,1459,1491,1523,1811,1843,1875,1907,1939,1971,2003,2035,
    32773,32789,32805,32821,32837,32853,32869,32885,32901,32917,32933,32949,32965,32981,32997,33013,33029,33045,33061,33077,33093,33109,33125,33141,33157,33173,33189,33205,33221,33237,33253,33269,
    33285,33301,33317,33333,33349,33365,33381,33397,33413,33429,33445,33461,33477,33493,33509,33525,33541,33557,33573,33589,33605,33621,33637,33653,33669,33685,33701,33717,33733,33749,33765,33781,
    274,306,338,370,402,434,466,498,786,818,850,882,914,946,978,1010,1298,1330,1362,1394,1426,1458,1490,1522,1810,1842,1874,1906,1938,1970,2002,2034,
    273,305,337,369,401,433,465,497,785,817,849,881,913,945,977,1009,1297,1329,1361,1393,1425,1457,1489,1521,1809,1841,1873,1905,1937,1969,2001,2033,
    208,209,210,211,212,213,214,215,216,217,218,219,220,221,222,223,240,241,242,243,244,245,246,247,248,249,250,251,252,253,254,255,
    272,304,336,368,400,432,464,496,720,721,722,723,724,725,726,727,728,729,730,731,732,733,734,735,752,753,754,755,756,757,758,759,
    760,761,762,763,764,765,766,767,784,816,848,880,912,944,976,1008,1232,1233,1234,1235,1236,1237,1238,1239,1240,1241,1242,1243,1244,1245,1246,1247,
    1264,1265,1266,1267,1268,1269,1270,1271,1272,1273,1274,1275,1276,1277,1278,1279,1296,1328,1360,1392,1424,1456,1488,1520,1744,1745,1746,1747,1748,1749,1750,1751,
    1752,1753,1754,1755,1756,1757,1758,1759,1776,1777,1778,1779,1780,1781,1782,1783,1784,1785,1786,1787,1788,1789,1790,1791,1808,1840,1872,1904,1936,1968,2000,2032,
    32772,32788,32804,32820,32836,32852,32868,32884,32900,32916,32932,32948,32964,32980,32996,33012,33028,33044,33060,33076,33092,33108,33124,33140,33156,33172,33188,33204,33220,33236,33252,33268,
    33284,33300,33316,33332,33348,33364,33380,33396,33412,33428,33444,33460,33476,33492,33508,33524,33540,33556,33572,33588,33604,33620,33636,33652,33668,33684,33700,33716,33732,33748,33764,33780,
    207,239,271,303,335,367,399,431,463,495,719,751,783,815,847,879,911,943,975,1007,1231,1263,1295,1327,1359,1391,1423,1455,1487,1519,1743,1775,
    1807,1839,1871,1903,1935,1967,1999,2031,206,238,270,302,334,366,398,430,462,494,718,750,782,814,846,878,910,942,974,1006,1230,1262,1294,1326,
    1358,1390,1422,1454,1486,1518,1742,1774,1806,1838,1870,1902,1934,1966,1998,2030,205,237,269,301,333,365,397,429,461,493,717,749,781,813,845,877,
    909,941,973,1005,1229,1261,1293,1325,1357,1389,1421,1453,1485,1517,1741,1773,1805,1837,1869,1901,1933,1965,1997,2029,32771,32787,32803,32819,32835,32851,32867,32883,
    32899,32915,32931,32947,32963,32979,32995,33011,33027,33043,33059,33075,33091,33107,33123,33139,33155,33171,33187,33203,33219,33235,33251,33267,33283,33299,33315,33331,33347,33363,33379,33395,
    33411,33427,33443,33459,33475,33491,33507,33523,33539,33555,33571,33587,33603,33619,33635,33651,33667,33683,33699,33715,33731,33747,33763,33779,204,236,268,300,332,364,396,428,
    460,492,716,748,780,812,844,876,908,940,972,1004,1228,1260,1292,1324,1356,1388,1420,1452,1484,1516,1740,1772,1804,1836,1868,1900,1932,1964,1996,2028,
    203,235,267,299,331,363,395,427,459,491,715,747,779,811,843,875,907,939,971,1003,1227,1259,1291,1323,1355,1387,1419,1451,1483,1515,1739,1771,
    1803,1835,1867,1899,1931,1963,1995,2027,202,234,266,298,330,362,394,426,458,490,714,746,778,810,842,874,906,938,970,1002,1226,1258,1290,1322,
    1354,1386,1418,1450,1482,1514,1738,1770,1802,1834,1866,1898,1930,1962,1994,2026,201,233,265,297,329,361,393,425,457,489,713,745,777,809,841,873,
    905,937,969,1001,1225,1257,1289,1321,1353,1385,1417,1449,1481,1513,1737,1769,1801,1833,1865,1897,1929,1961,1993,2025,32770,32786,32802,32818,32834,32850,32866,32882,
    32898,32914,32930,32946,32962,32978,32994,33010,33026,33042,33058,33074,33090,33106,33122,33138,33154,33170,33186,33202,33218,33234,33250,33266,33282,33298,33314,33330,33346,33362,33378,33394,
    33410,33426,33442,33458,33474,33490,33506,33522,33538,33554,33570,33586,33602,33618,33634,33650,33666,33682,33698,33714,33730,33746,33762,33778,136,137,138,139,140,141,142,143,
    144,145,146,147,148,149,150,151,152,153,154,155,156,157,158,159,168,169,170,171,172,173,174,175,176,177,178,179,180,181,182,183,
    184,185,186,187,188,189,190,191,200,232,264,296,328,360,392,424,456,488,648,649,650,651,652,653,654,655,656,657,658,659,660,661,
    662,663,664,665,666,667,668,669,670,671,680,681,682,683,684,685,686,687,688,689,690,691,692,693,694,695,696,697,698,699,700,701,
    702,703,712,744,776,808,840,872,904,936,968,1000,1160,1161,1162,1163,1164,1165,1166,1167,1168,1169,1170,1171,1172,1173,1174,1175,1176,1177,1178,1179,
    1180,1181,1182,1183,1192,1193,1194,1195,1196,1197,1198,1199,1200,1201,1202,1203,1204,1205,1206,1207,1208,1209,1210,1211,1212,1213,1214,1215,1224,1256,1288,1320,
    1352,1384,1416,1448,1480,1512,1672,1673,1674,1675,1676,1677,1678,1679,1680,1681,1682,1683,1684,1685,1686,1687,1688,1689,1690,1691,1692,1693,1694,1695,1704,1705,
    1706,1707,1708,1709,1710,1711,1712,1713,1714,1715,1716,1717,1718,1719,1720,1721,1722,1723,1724,1725,1726,1727,1736,1768,1800,1832,1864,1896,1928,1960,1992,2024,
    135,167,199,231,263,295,327,359,391,423,455,487,647,679,711,743,775,807,839,871,903,935,967,999,1159,1191,1223,1255,1287,1319,1351,1383,
    1415,1447,1479,1511,1671,1703,1735,1767,1799,1831,1863,1895,1927,1959,1991,2023,134,166,198,230,262,294,326,358,390,422,454,486,646,678,710,742,
    774,806,838,870,902,934,966,998,1158,1190,1222,1254,1286,1318,1350,1382,1414,1446,1478,1510,1670,1702,1734,1766,1798,1830,1862,1894,1926,1958,1990,2022,
    32769,32785,32801,32817,32833,32849,32865,32881,32897,32913,32929,32945,32961,32977,32993,33009,33025,33041,33057,33073,33089,33105,33121,33137,33153,33169,33185,33201,33217,33233,33249,33265,
    33281,33297,33313,33329,33345,33361,33377,33393,33409,33425,33441,33457,33473,33489,33505,33521,33537,33553,33569,33585,33601,33617,33633,33649,33665,33681,33697,33713,33729,33745,33761,33777,
    133,165,197,229,261,293,325,357,389,421,453,485,645,677,709,741,773,805,837,869,901,933,965,997,1157,1189,1221,1253,1285,1317,1349,1381,
    1413,1445,1477,1509,1669,1701,1733,1765,1797,1829,1861,1893,1925,1957,1989,2021,68,69,70,71,72,73,74,75,76,77,78,79,80,81,82,83,
    84,85,86,87,88,89,90,91,92,93,94,95,100,101,102,103,104,105,106,107,108,109,110,111,112,113,114,115,116,117,118,119,
    120,121,122,123,124,125,126,127,132,164,196,228,260,292,324,356,388,420,452,484,580,581,582,583,584,585,586,587,588,589,590,591,
    592,593,594,595,596,597,598,599,600,601,602,603,604,605,606,607,612,613,614,615,616,617,618,619,620,621,622,623,624,625,626,627,
    628,629,630,631,632,633,634,635,636,637,638,639,644,676,708,740,772,804,836,868,900,932,964,996,1092,1093,1094,1095,1096,1097,1098,1099,
    1100,1101,1102,1103,1104,1105,1106,1107,1108,1109,1110,1111,1112,1113,1114,1115,1116,1117,1118,1119,1124,1125,1126,1127,1128,1129,1130,1131,1132,1133,1134,1135,
    1136,1137,1138,1139,1140,1141,1142,1143,1144,1145,1146,1147,1148,1149,1150,1151,1156,1188,1220,1252,1284,1316,1348,1380,1412,1444,1476,1508,1604,1605,1606,1607,
    1608,1609,1610,1611,1612,1613,1614,1615,1616,1617,1618,1619,1620,1621,1622,1623,1624,1625,1626,1627,1628,1629,1630,1631,1636,1637,1638,1639,1640,1641,1642,1643,
    1644,1645,1646,1647,1648,1649,1650,1651,1652,1653,1654,1655,1656,1657,1658,1659,1660,1661,1662,1663,1668,1700,1732,1764,1796,1828,1860,1892,1924,1956,1988,2020,
    67,99,131,163,195,227,259,291,323,355,387,419,451,483,579,611,643,675,707,739,771,803,835,867,899,931,963,995,1091,1123,1155,1187,
    1219,1251,1283,1315,1347,1379,1411,1443,1475,1507,1603,1635,1667,1699,1731,1763,1795,1827,1859,1891,1923,1955,1987,2019,32768,32784,32800,32816,32832,32848,32864,32880,
    32896,32912,32928,32944,32960,32976,32992,33008,33024,33040,33056,33072,33088,33104,33120,33136,33152,33168,33184,33200,33216,33232,33248,33264,33280,33296,33312,33328,33344,33360,33376,33392,
    33408,33424,33440,33456,33472,33488,33504,33520,33536,33552,33568,33584,33600,33616,33632,33648,33664,33680,33696,33712,33728,33744,33760,33776,2,3,4,5,6,7,8,9,
    10,11,12,13,14,15,16,17,18,19,20,21,22,23,24,25,26,27,28,29,30,31,34,35,36,37,38,39,40,41,42,43,
    44,45,46,47,48,49,50,51,52,53,54,55,56,57,58,59,60,61,62,63,66,98,130,162,194,226,258,290,322,354,386,418,
    450,482,514,515,516,517,518,519,520,521,522,523,524,525,526,527,528,529,530,531,532,533,534,535,536,537,538,539,540,541,542,543,
    546,547,548,549,550,551,552,553,554,555,556,557,558,559,560,561,562,563,564,565,566,567,568,569,570,571,572,573,574,575,578,610,
    642,674,706,738,770,802,834,866,898,930,962,994,1026,1027,1028,1029,1030,1031,1032,1033,1034,1035,1036,1037,1038,1039,1040,1041,1042,1043,1044,1045,
    1046,1047,1048,1049,1050,1051,1052,1053,1054,1055,1058,1059,1060,1061,1062,1063,1064,1065,1066,1067,1068,1069,1070,1071,1072,1073,1074,1075,1076,1077,1078,1079,
    1080,1081,1082,1083,1084,1085,1086,1087,1090,1122,1154,1186,1218,1250,1282,1314,1346,1378,1410,1442,1474,1506,1538,1539,1540,1541,1542,1543,1544,1545,1546,1547,
    1548,1549,1550,1551,1552,1553,1554,1555,1556,1557,1558,1559,1560,1561,1562,1563,1564,1565,1566,1567,1570,1571,1572,1573,1574,1575,1576,1577,1578,1579,1580,1581,
    1582,1583,1584,1585,1586,1587,1588,1589,1590,1591,1592,1593,1594,1595,1596,1597,1598,1599,1602,1634,1666,1698,1730,1762,1794,1826,1858,1890,1922,1954,1986,2018,
    1,33,65,97,129,161,193,225,257,289,321,353,385,417,449,481,513,545,577,609,641,673,705,737,769,801,833,865,897,929,961,993,
    1025,1057,1089,1121,1153,1185,1217,1249,1281,1313,1345,1377,1409,1441,1473,1505,1537,1569,1601,1633,1665,1697,1729,1761,1793,1825,1857,1889,1921,1953,1985,2017,
    0,32,64,96,128,160,192,224,256,288,320,352,384,416,448,480,512,544,576,608,640,672,704,736,768,800,832,864,896,928,960,992,
    1024,1056,1088,1120,1152,1184,1216,1248,1280,1312,1344,1376,1408,1440,1472,1504,1536,1568,1600,1632,1664,1696,1728,1760,1792,1824,1856,1888,1920,1952,1984,2016,
};

struct Args { const float* in[15]; float* out; unsigned char* ws; int ph_lo, ph_hi; };
__global__ void __launch_bounds__(NWAVES * 64, 2) hybrid_fwd(Args args) {
    extern __shared__ __attribute__((aligned(16))) unsigned char lds[];
    cg::grid_group grid = cg::this_grid();
    const int wave = __builtin_amdgcn_readfirstlane((int)threadIdx.x >> 6);
#define lane lane_id()
#define tid (wave * 64 + lane_id())
    const int G = gridDim.x, bx = blockIdx.x, vcu = (G % 8 == 0) ? (bx % 8) * (G / 8) + bx / 8 : bx;
    const int gw = vcu * NWAVES + wave, NGW = G * NWAVES;
    unsigned char* ws = args.ws;
    const float* x = args.in[0]; const float* meta = args.in[1]; const float* g_pre = args.in[2]; const float* w_in = args.in[3];
    const float* lq1 = args.in[4]; const float* lk1 = args.in[5]; const float* lq2 = args.in[6]; const float* lk2 = args.in[7];
    const float* subln = args.in[8]; const float* g_cq = args.in[9]; const float* g_ckv = args.in[10];
    const float* w_uq = args.in[11]; const float* w_ukv = args.in[12]; const float* w_out = args.in[13]; const float* g_post = args.in[14];
    float* out = args.out;
    bf16* Wt_in = (bf16*)(ws + WS_WIN); bf16* Wt_uq = (bf16*)(ws + WS_WUQ); bf16* Wt_ukv = (bf16*)(ws + WS_WUKV); bf16* Wt_out = (bf16*)(ws + WS_WOUT);
    float* cosT = (float*)(ws + WS_TAB); float* sinT = cosT + 4112 * 32;
    float* KN2 = (float*)(ws + WS_TAB + 1536 * 1024); float* QST = KN2 + 16 * 4 * 65; float* CKVM = QST + 16 * 4 * 128;
    bf16* XN = (bf16*)(ws + WS_XN); bf16* MIX = XN;
    bf16* QD = (bf16*)(ws + WS_QD); bf16* KD = (bf16*)(ws + WS_KD); bf16* VD = (bf16*)(ws + WS_VD); bf16* GD = (bf16*)(ws + WS_GD);
    bf16* CQ = (bf16*)(ws + WS_CQ); bf16* CKV = (bf16*)(ws + WS_CKV); bf16* GM = (bf16*)(ws + WS_GM); bf16* KR = (bf16*)(ws + WS_KR);
    bf16* QN = (bf16*)(ws + WS_QN); bf16* QR = (bf16*)(ws + WS_QR); bf16* KV = (bf16*)(ws + WS_KV);
    bf16* Y16 = (bf16*)(ws + WS_QD);     bf16* O1 = (bf16*)(ws + WS_O1); bf16* O2 = (bf16*)(ws + WS_O2); bf16* OB = (bf16*)(ws + WS_OB);
    const int lo = args.ph_lo, hi_ph = args.ph_hi;
    for (int w_ = tid; w_ < (LDS_BYTES - LDSCTL_OFF) / 4; w_ += NWAVES * 64) ((LAS unsigned*)((LAS unsigned char*)lds + LDSCTL_OFF))[w_] = 0u;
    __syncthreads();
    XcdBarrier bar = xcd_barrier_post((unsigned*)(ws + WS_CTL), (volatile LAS unsigned*)((LAS unsigned char*)lds + MISC_OFF) + 8, wave);
    if (lo == 0x7fffffff) grid.sync();
#ifndef PH_MASK
#define PH_MASK 0xff
#endif
#define IN(k) (((PH_MASK >> (k)) & 1) && lo <= (k) && (k) < hi_ph)
#ifndef REP_MASK
#define REP_MASK 0
#endif
#define REP(k) (((REP_MASK >> (k)) & 1) ? 2 : 1)
#define SEAM(k) do { if (lo <= (k) && (k) + 1 < hi_ph) xcd_barrier(bar); } while (0)

    if (IN(0)) for (int rep_ = 0; rep_ < REP(0); ++rep_) {
        LAS float* scr = (LAS float*)((LAS unsigned char*)lds + wave * 16640);
        constexpr int I_INA = (4096 / 64) * (12288 / 64), I_INB = (4096 / 64) * (256 / 64), I_UQA = (Q_LORA / 64) * (2048 / 64), I_UQB = (Q_LORA / 64) * (1024 / 64), I_UKV = (KV_LORA / 64) * (4096 / 64), I_OUT = (4096 / 64) * (4096 / 64);
        constexpr int NITEMS = I_INA + I_INB + I_UQA + I_UQB + I_UKV + I_OUT;
        for (int it = gw; it < NITEMS; it += NGW) {
            int r = it;
            if (r < I_INA) { p0_transpose_item<false>(w_in, 4096, 12352, 12288, Wt_in, scr, r, lane, MapIn{}); continue; } r -= I_INA;
            if (r < I_INB) { p0_transpose_item<true>(w_in, 4096, 12352, 256, Wt_in + (size_t)12288 * 4096, scr, r, lane, MapInB{}); continue; } r -= I_INB;
            if (r < I_UQA) { p0_transpose_item<false>(w_uq, Q_LORA, 3072, 2048, Wt_uq, scr, r, lane, MapUq{}); continue; } r -= I_UQA;
            if (r < I_UQB) { p0_transpose_item<true>(w_uq, Q_LORA, 3072, 1024, Wt_uq + (size_t)2048 * Q_LORA, scr, r, lane, MapUqB{}); continue; } r -= I_UQB;
            if (r < I_UKV) { p0_transpose_item<false>(w_ukv, KV_LORA, 4096, 4096, Wt_ukv, scr, r, lane, MapId{}); continue; } r -= I_UKV;
            p0_transpose_item<false>(w_out, 4096, 4096, 4096, Wt_out, scr, r, lane, MapId{});
        }
        for (int m = gw; m < MP; m += NGW) {
            if (m < MR) rms_row_to_bf16(x + (size_t)m * D_MODEL, g_pre, XN + (size_t)m * D_MODEL, lane);
            else { const int mm = (m - MR) & 63;
                if (mm < N_META) rms_row_to_bf16(meta + (size_t)mm * D_MODEL, g_pre, XN + (size_t)m * D_MODEL, lane);
                else { v4u z = {0u, 0u, 0u, 0u}; v4u* o = (v4u*)(XN + (size_t)m * D_MODEL) + lane;
#pragma unroll
                    for (int j = 0; j < 8; ++j) o[64 * j] = z; } }
        }
        for (int blk = gw; blk < 256; blk += NGW) { const int tns = blk >> 6, hb = blk & 63;
            bf16* base = (tns == 0 ? KD : tns == 1 ? VD : KV + (size_t)(tns - 2) * 16 * MP * 128) + ((size_t)(hb >> 2) * MP + MR + 64 * (hb & 3) + 16) * 128;
            const v4u z = {0u, 0u, 0u, 0u};
#pragma unroll
            for (int j = 0; j < 12; ++j) ((v4u*)base)[64 * j + lane] = z; }
        for (int e = gw * 64 + lane; e < 4112 * 32; e += NGW * 64) { const int pos = e >> 5, i = e & 31;
            const float inv_freq = exp2f(-(float)(2 * i) * (13.287712379549449f / 64.f));
            const double rev = (double)pos * (double)inv_freq * 0.15915494309189535; const float fr = (float)(rev - floor(rev));
            cosT[e] = __builtin_amdgcn_cosf(fr); sinT[e] = __builtin_amdgcn_sinf(fr); }
    }
    SEAM(0);
    if (IN(1)) for (int rep_ = 0; rep_ < (REP(1) == 2 ? hi_ph - 6 : 1); ++rep_) {
        pg8::Gemm g{XN, Wt_in, MR, 12288, 4096}; pg8::StaticOrder S; S.init(MR, 12288, G, bx);
        pg8::EpiZ E{QD, KD, VD, GD, CQ, CKV, GM, KR, cosT, sinT, 0.08838834764831845f};
        pg8::gemm_phase<pg8::EpiZ, pg8::StaticOrder, false, true>((LAS unsigned char*)lds, g, S, E, wave);
    }
    SEAM(1);
    if (IN(2)) {
        f32x4 gq[6], gk[2];
#pragma unroll
        for (int j = 0; j < 3; ++j) { gq[2 * j] = *(const f32x4*)(g_cq + 512 * j + 8 * lane); gq[2 * j + 1] = *(const f32x4*)(g_cq + 512 * j + 8 * lane + 4); }
        gk[0] = *(const f32x4*)(g_ckv + 8 * lane); gk[1] = *(const f32x4*)(g_ckv + 8 * lane + 4);
        for (int rep_ = 0; rep_ < (REP(9) == 2 ? hi_ph - 6 : 1); ++rep_) if (G == 256) { LAS float* red = (LAS float*)lds; const int c = lane & 15, q = lane >> 4;
            if (vcu < 208) { const int r0 = 80 * vcu; f32x4 res[5];
                wg_task<5, 4>(XN + (size_t)r0 * 4096, Wt_in + (size_t)12288 * 4096, red, res, wave, lane);
                if (wave < 4) {
#pragma unroll
                    for (int rb = 0; rb < 5; ++rb)
#pragma unroll
                        for (int rg = 0; rg < 4; ++rg) { const int row = r0 + 16 * rb + 4 * q + rg, pos = row < MR ? 16 + (row & 4095) : ((row - MR) & 63), col = 16 * wave + c;
                            const float xs = res[rb][rg], xo = __shfl_xor(xs, 1), cs = cosT[pos * 32 + (col >> 1)], sn = sinT[pos * 32 + (col >> 1)];
                            if ((c & 1) == 0) *(unsigned*)(KR + (size_t)row * 64 + col) = pk2(xs * cs - xo * sn, xs * sn + xo * cs); } }
            } else if (vcu < 240) { const int tsk = vcu - 208, isv = tsk >> 4, n0 = (isv ? 4096 : 2048) + 128 * (tsk & 15); f32x4 res[2];
                wg_task<1, 8>(XN + (size_t)MR * 4096, Wt_in + (size_t)n0 * 4096, red, res, wave, lane);
                bf16* dst = (isv ? VD : KD) + (size_t)(tsk & 15) * MP * 128;
                if (wave < 4) {
#pragma unroll
                    for (int r = 0; r < 2; ++r)
#pragma unroll
                        for (int rg = 0; rg < 4; ++rg) { const int d = 16 * (4 * r + wave) + c; const float xs = res[r][rg], xo = __shfl_xor(xs, 1);
                            if ((c & 1) == 0) { const unsigned w = pk2(xs, xo);
#pragma unroll
                                for (int b = 0; b < 4; ++b) *(unsigned*)(dst + ((size_t)MR + 64 * b + 4 * q + rg) * 128 + d) = w; } } }
            } else if (vcu < 244) { const int tsk = vcu - 240; f32x4 res[2];
                wg_task<1, 8>(XN + (size_t)MR * 4096, Wt_in + (size_t)(9728 + 128 * tsk) * 4096, red, res, wave, lane);
                if (wave < 4) {
#pragma unroll
                    for (int r = 0; r < 2; ++r)
#pragma unroll
                        for (int rg = 0; rg < 4; ++rg) CKVM[(4 * q + rg) * 512 + 128 * tsk + 16 * (4 * r + wave) + c] = res[r][rg]; }
            }
        }
        for (int m = gw; m < MR; m += NGW) {
            { v4u* p = (v4u*)(CQ + (size_t)m * Q_LORA) + lane; v4u v[3]; float s = 0.f;
#pragma unroll
                for (int j = 0; j < 3; ++j) { v[j] = p[64 * j];
#pragma unroll
                    for (int e = 0; e < 4; ++e) { const float a = bflo(v[j][e]), b = bfhi(v[j][e]); s += a * a + b * b; } }
                const float rstd = 1.f / sqrtf(wave_sum(s) * (1.f / Q_LORA) + RMS_EPS);
#pragma unroll
                for (int j = 0; j < 3; ++j) { v4u o;
#pragma unroll
                    for (int e = 0; e < 4; ++e) { const f32x4 gg = gq[2 * j + (e >> 1)];
                        o[e] = pk2(bflo(v[j][e]) * rstd * gg[(e & 1) * 2], bfhi(v[j][e]) * rstd * gg[(e & 1) * 2 + 1]); }
                    p[64 * j] = o; } }
            { v4u* p = (v4u*)(CKV + (size_t)m * KV_LORA) + lane; v4u v = p[0]; float s = 0.f;
#pragma unroll
                for (int e = 0; e < 4; ++e) { const float a = bflo(v[e]), b = bfhi(v[e]); s += a * a + b * b; }
                const float rstd = 1.f / sqrtf(wave_sum(s) * (1.f / KV_LORA) + RMS_EPS); v4u o;
#pragma unroll
                for (int e = 0; e < 4; ++e) { const f32x4 gg = gk[e >> 1]; o[e] = pk2(bflo(v[e]) * rstd * gg[(e & 1) * 2], bfhi(v[e]) * rstd * gg[(e & 1) * 2 + 1]); }
                p[0] = o; }
        }
        for (int rep_ = 0; rep_ < REP(10); ++rep_) for (int id = gw; id < 16 * 4 * 64; id += NGW) { const int hm = id >> 8, b = (id >> 6) & 3, tt = (id & 63) + 1;
            const size_t r0 = (size_t)hm * MP + (tt == 0 ? (size_t)MR + 64 * b : (size_t)b * SEQ + 64 * (tt - 1));
            float kmax = 0.f, qmax = 0.f, smin = 3.0e38f;
#pragma unroll 4
            for (int i = 0; i < 16; ++i) { const size_t off = (r0 + 4 * i + (lane >> 4)) * 128 + 8 * (lane & 15);
                const v4u k8 = *(const v4u*)(KD + off); const v4u q8 = tt ? *(const v4u*)(QD + off) : (v4u){0u, 0u, 0u, 0u};
                float kk = 0.f, qq = 0.f, qk = 0.f;
#pragma unroll
                for (int e = 0; e < 4; ++e) { const float k0 = bflo(k8[e]), k1 = bfhi(k8[e]), q0 = bflo(q8[e]), q1 = bfhi(q8[e]); kk += k0 * k0 + k1 * k1; qq += q0 * q0 + q1 * q1; qk += q0 * k0 + q1 * k1; }
#pragma unroll
                for (int o = 1; o < 16; o <<= 1) { kk += __shfl_xor(kk, o); qq += __shfl_xor(qq, o); qk += __shfl_xor(qk, o); }
                kmax = fmaxf(kmax, kk); qmax = fmaxf(qmax, qq); smin = fminf(smin, qk); }
            kmax = fmaxf(kmax, __shfl_xor(kmax, 16)); kmax = fmaxf(kmax, __shfl_xor(kmax, 32));
            qmax = fmaxf(qmax, __shfl_xor(qmax, 16)); qmax = fmaxf(qmax, __shfl_xor(qmax, 32));
            smin = fminf(smin, __shfl_xor(smin, 16)); smin = fminf(smin, __shfl_xor(smin, 32));
            if (lane == 0) { KN2[(hm * 4 + b) * 65 + tt] = kmax; if (tt) { QST[((hm * 4 + b) * 64 + tt - 1) * 2] = qmax; QST[((hm * 4 + b) * 64 + tt - 1) * 2 + 1] = smin; } }
        }
    }
    SEAM(2);
    if (IN(3)) for (int rep_ = 0; rep_ < REP(3); ++rep_) {
        if (rep_ == 0 && gw < 64) { const int c = lane & 15, q = lane >> 4; f32x4 acc[4];
            const float* xrow = CKVM + c * 512 + 8 * q; float ss = 0.f;
#pragma unroll
            for (int s = 0; s < 16; ++s) { const f32x4 x0 = *(const f32x4*)(xrow + 32 * s), x1 = *(const f32x4*)(xrow + 32 * s + 4);
                ss += (x0[0] * x0[0] + x0[1] * x0[1]) + (x0[2] * x0[2] + x0[3] * x0[3]) + (x1[0] * x1[0] + x1[1] * x1[1]) + (x1[2] * x1[2] + x1[3] * x1[3]); }
            ss += __shfl_xor(ss, 16); ss += __shfl_xor(ss, 32);
            const float rstd = 1.f / sqrtf(ss * (1.f / KV_LORA) + RMS_EPS);
            const bf16* bp = Wt_ukv + (size_t)(64 * gw + c) * KV_LORA + 8 * q;
#pragma unroll
            for (int nb = 0; nb < 4; ++nb) acc[nb] = (f32x4){0.f, 0.f, 0.f, 0.f};
#pragma unroll 4
            for (int s = 0; s < 16; ++s) { const f32x4 x0 = *(const f32x4*)(xrow + 32 * s), x1 = *(const f32x4*)(xrow + 32 * s + 4);
                const f32x4 g0 = *(const f32x4*)(g_ckv + 32 * s + 8 * q), g1 = *(const f32x4*)(g_ckv + 32 * s + 8 * q + 4);
                v4u aw; aw.x = pk2(x0[0] * rstd * g0[0], x0[1] * rstd * g0[1]); aw.y = pk2(x0[2] * rstd * g0[2], x0[3] * rstd * g0[3]);
                aw.z = pk2(x1[0] * rstd * g1[0], x1[1] * rstd * g1[1]); aw.w = pk2(x1[2] * rstd * g1[2], x1[3] * rstd * g1[3]);
                const bf16x8 a = __builtin_bit_cast(bf16x8, aw);
#pragma unroll
                for (int nb = 0; nb < 4; ++nb) { const bf16x8 b = *(const bf16x8*)(bp + (size_t)nb * 16 * KV_LORA + 32 * s); acc[nb] = __builtin_amdgcn_mfma_f32_16x16x32_bf16(a, b, acc[nb], 0, 0, 0); } }
#pragma unroll
            for (int nb = 0; nb < 4; ++nb)
#pragma unroll
                for (int rg = 0; rg < 4; ++rg) { const int nn = 64 * gw + 16 * nb + c, hh = nn >> 7, d = nn & 127;
                    const float xs = acc[nb][rg], xo = __shfl_xor(xs, 1);
                    if ((c & 1) == 0) { const unsigned w = pk2(xs, xo);
#pragma unroll
                        for (int b = 0; b < 4; ++b) *(unsigned*)(KV + ((size_t)hh * MP + MR + 64 * b + 4 * q + rg) * 128 + d) = w; } }
        }
        { pg8::Gemm g{CQ, Wt_uq, MR, 3072, Q_LORA}; pg8::StaticOrder S; S.init(MR, 3072, G, bx);
          pg8::EpiQ E{QN, QR, cosT, sinT, 0.07216878364870323f * LOG2E};
          pg8::gemm_phase<pg8::EpiQ, pg8::StaticOrder, false, true>((LAS unsigned char*)lds, g, S, E, wave); }
        { pg8::Gemm g{CKV, Wt_ukv, MR, 4096, KV_LORA}; pg8::StaticOrder S; S.init(MR, 4096, G, bx);
          pg8::EpiKV E{KV};
          pg8::gemm_phase<pg8::EpiKV, pg8::StaticOrder, false, true>((LAS unsigned char*)lds, g, S, E, wave); }
    }
    SEAM(3);
    if (IN(4)) {
        unsigned* qctr = (unsigned*)(ws + WS_CTL) + 3600;
        volatile LAS unsigned* qslot = (volatile LAS unsigned*)((LAS unsigned char*)lds + MISC_OFF) + 16;
        if (tid == 0) { const unsigned t_ = __hip_atomic_fetch_add(qctr, 1u, __ATOMIC_RELAXED, __HIP_MEMORY_SCOPE_AGENT); qslot[0] = t_ < 3072u ? (unsigned)ATT_ORDER[t_] : 0xffffffffu; }
        for (;;) {
            __syncthreads();
            const unsigned code = (unsigned)__builtin_amdgcn_readfirstlane((int)qslot[0]);
            __syncthreads();
            if (code == 0xffffffffu) break;
            unsigned nxt_ = 0u;
            if (tid == 0) nxt_ = __hip_atomic_fetch_add(qctr, 1u, __ATOMIC_RELAXED, __HIP_MEMORY_SCOPE_AGENT);
            att::Unit u;
            if (!(code & 0x8000u)) { const int qb = code & 31, mp = (code >> 5) & 1, h = (code >> 6) & 7, b = (code >> 9) & 3; att::UnitX ux;
                const size_t qrow = (size_t)b * SEQ + (size_t)qb * 128, mrow = (size_t)MR + 64 * b, hq = (size_t)(h * 2 + mp) * MP, hv0 = (size_t)(h * 2) * MP, hv1 = (size_t)(h * 2 + 1) * MP;
                ux.Q = QD + (hq + qrow) * 128; ux.Kr = KD + (hq + (size_t)b * SEQ) * 128; ux.Km = KD + (hq + mrow) * 128;
                ux.V0r = VD + (hv0 + (size_t)b * SEQ) * 128; ux.V0m = VD + (hv0 + mrow) * 128; ux.V1r = VD + (hv1 + (size_t)b * SEQ) * 128; ux.V1m = VD + (hv1 + mrow) * 128;
                ux.O = (mp ? O2 : O1) + qrow * 2048 + h * 256; ux.qb = qb; ux.nslope = -exp2f(-(float)(h + 1)); ux.kn2 = KN2 + ((h * 2 + mp) * 4 + b) * 65; ux.qst = QST + ((h * 2 + mp) * 4 + b) * 128;
                att::attn_unit_x<2048>(ux, (char*)lds, wave);
            } else { const int qb = code & 15, h = (code >> 4) & 15, b = (code >> 8) & 3;
                const size_t qrow = (size_t)b * SEQ + (size_t)qb * 256, mrow = (size_t)MR + 64 * b, hk = (size_t)(2 * h) * MP, hv = (size_t)(2 * h + 1) * MP;
                u.Q = QN + ((size_t)h * MR + qrow) * 128; u.Q2 = QR + ((size_t)h * MR + qrow) * 64;
                u.Kr = KV + (hk + (size_t)b * SEQ) * 128; u.Km = KV + (hk + mrow) * 128;
                u.K2r = KR + (size_t)b * SEQ * 64; u.K2m = KR + mrow * 64;
                u.Vr = KV + (hv + (size_t)b * SEQ) * 128; u.Vm = KV + (hv + mrow) * 128;
                u.O = OB + qrow * 2048 + h * 128; u.qb = qb; u.nslope2 = 0.f; u.kn2 = nullptr; u.qst = nullptr;
                att::attn_unit<true, false, 128, 64, 128, 128, 2048>(u, (char*)lds, wave); }
            if (tid == 0) qslot[0] = nxt_ < 3072u ? (unsigned)ATT_ORDER[nxt_] : 0xffffffffu;
        }
    }
    SEAM(4);
    if (IN(5)) for (int rep_ = 0; rep_ < REP(5); ++rep_) {
        float lam;
        { const float a = lq1[lane] * lk1[lane] + lq1[lane + 64] * lk1[lane + 64], c = lq2[lane] * lk2[lane] + lq2[lane + 64] * lk2[lane + 64];
          lam = __expf(wave_sum(a)) - __expf(wave_sum(c)) + LAMBDA_INIT; }
        f32x4 sl0 = *(const f32x4*)(subln + (lane & 31) * 8), sl1 = *(const f32x4*)(subln + (lane & 31) * 8 + 4);
        for (int m = gw; m < MR; m += NGW) {
            const v4u* p1 = (const v4u*)(O1 + (size_t)m * 2048) + lane; const v4u* p2 = (const v4u*)(O2 + (size_t)m * 2048) + lane;
            const v4u* pg = (const v4u*)(GD + (size_t)m * 2048) + lane;
            const v4u* pb = (const v4u*)(OB + (size_t)m * 2048) + lane; const v4u* pm = (const v4u*)(GM + (size_t)m * 2048) + lane;
            v4u a[4], b[4], gt[4], ab[4], gm[4];
#pragma unroll
            for (int j = 0; j < 4; ++j) { a[j] = p1[64 * j]; b[j] = p2[64 * j]; gt[j] = pg[64 * j]; ab[j] = pb[64 * j]; gm[j] = pm[64 * j]; }
            v4u* po = (v4u*)(MIX + (size_t)m * 4096) + lane;
#pragma unroll
            for (int j = 0; j < 4; ++j) { float d[8]; float ss = 0.f;
#pragma unroll
                for (int e = 0; e < 4; ++e) { const float d0 = bflo(a[j][e]) - lam * bflo(b[j][e]), d1 = bfhi(a[j][e]) - lam * bfhi(b[j][e]); d[2 * e] = d0; d[2 * e + 1] = d1; ss += d0 * d0 + d1 * d1; }
                ss += __shfl_xor(ss, 1); ss += __shfl_xor(ss, 2); ss += __shfl_xor(ss, 4); ss += __shfl_xor(ss, 8); ss += __shfl_xor(ss, 16);
                const float rstd = (1.f - LAMBDA_INIT) / sqrtf(ss * (1.f / 256.f) + RMS_EPS); v4u o;
#pragma unroll
                for (int e = 0; e < 4; ++e) { const f32x4 s4 = (e >> 1) ? sl1 : sl0;
                    o[e] = pk2(d[2 * e] * rstd * s4[(e & 1) * 2] * silu(bflo(gt[j][e])), d[2 * e + 1] * rstd * s4[(e & 1) * 2 + 1] * silu(bfhi(gt[j][e]))); }
                po[64 * j] = o;
                v4u o2;
#pragma unroll
                for (int e = 0; e < 4; ++e) o2[e] = pk2(bflo(ab[j][e]) * silu(bflo(gm[j][e])), bfhi(ab[j][e]) * silu(bfhi(gm[j][e])));
                po[256 + 64 * j] = o2; }
        }
    }
    SEAM(5);
    if (IN(6)) for (int rep_ = 0; rep_ < REP(6); ++rep_) {
        pg8::Gemm g{MIX, Wt_out, MR, 4096, 4096}; pg8::StaticOrder S; S.init(MR, 4096, G, bx);
        pg8::EpiBf16<0> E{Y16, 4096, nullptr, 0, 0, 1.f};
        pg8::gemm_phase<pg8::EpiBf16<0>, pg8::StaticOrder, false, true>((LAS unsigned char*)lds, g, S, E, wave);
    }
    SEAM(6);
    if (IN(7)) {
        for (int m = gw; m < MR; m += NGW) {
            const v4u* yr = (const v4u*)(Y16 + (size_t)m * D_MODEL) + lane; f32x4* orow = (f32x4*)(out + (size_t)m * D_MODEL) + 2 * lane;
            const f32x4* xr = (const f32x4*)(x + (size_t)m * D_MODEL) + 2 * lane; const f32x4* gr = (const f32x4*)g_post + 2 * lane;
            v4u v[8]; float s = 0.f;
#pragma unroll
            for (int j = 0; j < 8; ++j) { v[j] = yr[64 * j];
#pragma unroll
                for (int e = 0; e < 4; ++e) { const float a = bflo(v[j][e]), b = bfhi(v[j][e]); s += a * a + b * b; } }
            const float rstd = 1.f / sqrtf(wave_sum(s) * (1.f / D_MODEL) + RMS_EPS);
#pragma unroll
            for (int j = 0; j < 8; ++j) { const f32x4 g0 = gr[128 * j], g1 = gr[128 * j + 1], x0 = __builtin_nontemporal_load(xr + 128 * j), x1 = __builtin_nontemporal_load(xr + 128 * j + 1);
                f32x4 y0 = {bflo(v[j][0]), bfhi(v[j][0]), bflo(v[j][1]), bfhi(v[j][1])}, y1 = {bflo(v[j][2]), bfhi(v[j][2]), bflo(v[j][3]), bfhi(v[j][3])};
                __builtin_nontemporal_store(x0 + y0 * rstd * g0, orow + 128 * j); __builtin_nontemporal_store(x1 + y1 * rstd * g1, orow + 128 * j + 1); }
        }
    }
#undef IN
#undef SEAM
#undef lane
#undef tid
}

extern "C" void kernel_launch(void* const* d_in, const int* in_sizes, int n_in, void* d_out, int out_size, void* d_ws, size_t ws_size, hipStream_t stream) {
    static int grid = 0;
    if (grid == 0) {
        if (n_in != 15 || out_size != MR * D_MODEL || ws_size < WS_END) { fprintf(stderr, "kernel_launch: unexpected shapes (n_in %d out %d ws %zu)\n", n_in, out_size, ws_size); grid = -1; return; }
        int dev = 0, cus = 0, per_cu = 0;
        (void)hipGetDevice(&dev); (void)hipDeviceGetAttribute(&cus, hipDeviceAttributeMultiprocessorCount, dev);
        if (hipFuncSetAttribute((const void*)hybrid_fwd, hipFuncAttributeMaxDynamicSharedMemorySize, LDS_BYTES) != hipSuccess) { fprintf(stderr, "kernel_launch: hipFuncSetAttribute failed\n"); grid = -1; return; }
        if (hipOccupancyMaxActiveBlocksPerMultiprocessor(&per_cu, (const void*)hybrid_fwd, NWAVES * 64, LDS_BYTES) != hipSuccess || per_cu < 1) per_cu = 1;
        (void)hipGetLastError();
        grid = cus * per_cu;
    }
    if (grid < 0) return;
    if (hipMemsetAsync((char*)d_ws + WS_CTL, 0, CTL_ZERO_BYTES, stream) != hipSuccess) { fprintf(stderr, "kernel_launch: memset failed\n"); return; }
    Args a{};
    for (int i = 0; i < 15; ++i) a.in[i] = (const float*)d_in[i];
    a.out = (float*)d_out; a.ws = (unsigned char*)d_ws; a.ph_lo = 0; a.ph_hi = 8;
    void* kargs[] = {&a};
    hipError_t e = hipLaunchCooperativeKernel((const void*)hybrid_fwd, dim3(grid), dim3(NWAVES * 64), kargs, LDS_BYTES, stream);
    if (e != hipSuccess) fprintf(stderr, "kernel_launch: cooperative launch failed: %s (grid %d)\n", hipGetErrorString(e), grid);
}
```

```cpp
#include <hip/hip_runtime.h>
#include <hip/hip_cooperative_groups.h>
#include <cstdio>
#include <cstdint>
namespace cg = cooperative_groups;
namespace pg8 {
#define PG8_LAS __attribute__((address_space(3)))
typedef unsigned short bf16_t;
typedef short bf16x8 __attribute__((ext_vector_type(8)));
typedef float f32x4 __attribute__((ext_vector_type(4)));
typedef unsigned u32x4 __attribute__((ext_vector_type(4)));
constexpr int BM = 256, BK = 64, HALF = 128, HTB = HALF * BK * 2  , STAGE_BYTES = 8 * HTB, NXCD = 8, WGM = 8;

__host__ __device__ __forceinline__ int lds_byte(int r, int c) { const int st = (r >> 4) * 2 + (c >> 5), rr = r & 15, cc = c & 31, ob = rr * 64 + cc * 2; return st * 1024 + (ob ^ (((ob >> 9) & 1) << 5)); }
__host__ __device__ __forceinline__ void stage_rc(int b, int& R, int& C) { const int st = b / 1024, sb = b % 1024, swz = sb ^ (((sb >> 9) & 1) << 5); R = (st >> 1) * 16 + swz / 64; C = (st & 1) * 32 + (swz % 64) / 2; }
__host__ __device__ __forceinline__ int perm32(int rho) { const int n = rho >> 4, i = rho & 15; return 8 * (i >> 2) + 4 * n + (i & 3); }

struct Unit { int pm, pn; };
struct Gemm { const bf16_t* A; const bf16_t* Bt; int M, N, K; };

struct StaticOrder {
    int nM, nN, nwg, G, c;
    __host__ __device__ void init(int M, int N, int G_, int c_) { nM = M / BM; nN = N / BM; nwg = nM * nN; G = G_; c = c_; }
    __host__ __device__ bool next(int i, Unit& u) const {
        const long L = (long)i * G + c; if (L >= nwg) return false;
        int wgid = (int)L; { const int q = nwg / NXCD, r = nwg % NXCD, xcd = wgid % NXCD, off = wgid / NXCD; wgid = (xcd < r ? xcd * (q + 1) : r * (q + 1) + (xcd - r) * q) + off; }
        const int nig = WGM * nN, gid = wgid / nig, fm = gid * WGM, gsz = (nM - fm) < WGM ? (nM - fm) : WGM;
        u.pm = fm + ((wgid % nig) % gsz); u.pn = (wgid % nig) / gsz; return true;
    }
    __device__ __forceinline__ void a_ready(const Unit&) const {}
    __device__ __forceinline__ void done(const Unit&) const {}
};

__device__ __forceinline__ unsigned cvt_pk_bf16(float lo, float hi) { unsigned r; asm volatile("v_cvt_pk_bf16_f32 %0, %1, %2" : "=v"(r) : "v"(lo), "v"(hi)); return r; }
typedef float f32x2 __attribute__((ext_vector_type(2)));
__device__ __forceinline__ f32x2 gelu_pk(f32x2 v) {
    const f32x2 av = __builtin_elementwise_abs(v), d = av * 0.2316418882f + 1.0f;
    f32x2 t; t.x = __builtin_amdgcn_rcpf(d.x); t.y = __builtin_amdgcn_rcpf(d.y);
    f32x2 q = t * 0.5307027145f + (-0.7265760135f); q = q * t + 0.7107068705f; q = q * t + (-0.142248368f); q = q * t + 0.127414796f; q = q * t;
    const f32x2 s = (v * v) * (-0.72134752044f);
    f32x2 e; e.x = __builtin_amdgcn_exp2f(s.x); e.y = __builtin_amdgcn_exp2f(s.y);
    const f32x2 m = v * (q * e), r = v - m;
    f32x2 o; o.x = v.x < 0.f ? m.x : r.x; o.y = v.y < 0.f ? m.y : r.y; return o;
}

template <int ACT  > struct EpiBf16 {
    static constexpr bool PERM = true, AFTER_DRAIN = false; static_assert(ACT == 0 || ACT == 1, "EpiBf16: ACT is 0 (none) or 1 (gelu_pk)");
    bf16_t* O; int ldc; const float* bias; int split_cols; size_t split_stride; float scale0;
    __device__ __forceinline__ void operator()(const f32x4 (&acc)[2][2][4][2], const Unit& u, int wr, int wc, int fr, int fq) const {
        const int row0 = u.pm * BM + wr * 64 + fr; int colt = u.pn * BM; bf16_t* base = O;
        float sc = 1.f; if (split_cols) { const int t = colt / split_cols; base += (size_t)t * split_stride; colt -= t * split_cols; if (t == 0) sc = scale0; }
        const int col0 = colt + wc * 32 + 8 * fq, bcol0 = u.pn * BM + wc * 32 + 8 * fq;
        f32x4 bv[2][2];
#pragma unroll
        for (int bj = 0; bj < 2; ++bj)
#pragma unroll
            for (int n = 0; n < 2; ++n) bv[bj][n] = bias ? *(const f32x4*)(bias + bcol0 + bj * HALF + 4 * n) : (f32x4){0.f, 0.f, 0.f, 0.f};
#pragma unroll
        for (int ai = 0; ai < 2; ++ai)
#pragma unroll
            for (int m = 0; m < 4; ++m) { bf16_t* rowp = base + (size_t)(row0 + ai * HALF + m * 16) * ldc + col0;
#pragma unroll
                for (int bj = 0; bj < 2; ++bj) { f32x4 v0 = acc[ai][bj][m][0] + bv[bj][0], v1 = acc[ai][bj][m][1] + bv[bj][1];
                    if (ACT == 1) { f32x2 a = gelu_pk((f32x2){v0[0], v0[1]}), b = gelu_pk((f32x2){v0[2], v0[3]}), c = gelu_pk((f32x2){v1[0], v1[1]}), d = gelu_pk((f32x2){v1[2], v1[3]});
                        v0 = (f32x4){a.x, a.y, b.x, b.y}; v1 = (f32x4){c.x, c.y, d.x, d.y}; }
                    v0 = v0 * sc; v1 = v1 * sc; u32x4 w; w.x = cvt_pk_bf16(v0[0], v0[1]); w.y = cvt_pk_bf16(v0[2], v0[3]); w.z = cvt_pk_bf16(v1[0], v1[1]); w.w = cvt_pk_bf16(v1[2], v1[3]);
                    *(u32x4*)(rowp + bj * HALF) = w; } }
    }
};
__device__ __forceinline__ u32x4 pack8s(f32x4 v0, f32x4 v1, float sc) {
    v0 = v0 * sc; v1 = v1 * sc; u32x4 w; w.x = cvt_pk_bf16(v0[0], v0[1]); w.y = cvt_pk_bf16(v0[2], v0[3]); w.z = cvt_pk_bf16(v1[0], v1[1]); w.w = cvt_pk_bf16(v1[2], v1[3]); return w;
}
__device__ __forceinline__ u32x4 rope8(f32x4 v0, f32x4 v1, const float* cosT, const float* sinT, int pos, int i0, float sc) {
    const f32x4 cs = *(const f32x4*)(cosT + pos * 32 + i0), sn = *(const f32x4*)(sinT + pos * 32 + i0);
    f32x4 a, b;
    a[0] = v0[0] * cs[0] - v0[1] * sn[0]; a[1] = v0[0] * sn[0] + v0[1] * cs[0];
    a[2] = v0[2] * cs[1] - v0[3] * sn[1]; a[3] = v0[2] * sn[1] + v0[3] * cs[1];
    b[0] = v1[0] * cs[2] - v1[1] * sn[2]; b[1] = v1[0] * sn[2] + v1[1] * cs[2];
    b[2] = v1[2] * cs[3] - v1[3] * sn[3]; b[3] = v1[2] * sn[3] + v1[3] * cs[3];
    return pack8s(a, b, sc);
}
struct EpiZ {
    static constexpr bool PERM = true, AFTER_DRAIN = false;
    static constexpr size_t MPR = 16640;
    bf16_t *QD, *KD, *VD, *GD, *CQ, *CKV, *GM, *KR; const float* cosT; const float* sinT; float scq;
    __device__ __forceinline__ void operator()(const f32x4 (&acc)[2][2][4][2], const Unit& u, int wr, int wc, int fr, int fq) const {
        const int colt = u.pn * BM; bf16_t* base; int ldc, c0; float sc = 1.f; bool rope = false;
        bool hm = false;
        if (colt < 2048) { base = QD + (size_t)(colt >> 8) * 2 * MPR * 128; hm = true; sc = scq; ldc = 128; c0 = 0; }
        else if (colt < 4096) { base = KD + (size_t)((colt - 2048) >> 8) * 2 * MPR * 128; hm = true; ldc = 128; c0 = 0; }
        else if (colt < 6144) { base = VD + (size_t)((colt - 4096) >> 8) * 2 * MPR * 128; hm = true; ldc = 128; c0 = 0; }
        else if (colt < 8192) { base = GD; ldc = 2048; c0 = colt - 6144; }
        else if (colt < 9728) { base = CQ; ldc = 1536; c0 = colt - 8192; }
        else if (colt < 10240) { base = CKV; ldc = 512; c0 = colt - 9728; }
        else if (colt < 12288) { base = GM; ldc = 2048; c0 = colt - 10240; }
        else { base = KR; ldc = 64; c0 = 0; rope = true; }
        const int row0 = u.pm * BM + wr * 64 + fr, lc = wc * 32 + 8 * fq;
        if (!rope) {
#pragma unroll
            for (int ai = 0; ai < 2; ++ai)
#pragma unroll
                for (int m = 0; m < 4; ++m) { bf16_t* rowp = base + (size_t)(row0 + ai * HALF + m * 16) * ldc + c0 + lc;
#pragma unroll
                    for (int bj = 0; bj < 2; ++bj) *(u32x4*)(rowp + (hm ? (size_t)bj * MPR * 128 : (size_t)(bj * HALF))) = pack8s(acc[ai][bj][m][0], acc[ai][bj][m][1], sc); }
        } else if (wc < 2) {
#pragma unroll
            for (int ai = 0; ai < 2; ++ai)
#pragma unroll
                for (int m = 0; m < 4; ++m) { const int row = row0 + ai * HALF + m * 16; const int pos = row < 16384 ? 16 + (row & 4095) : ((row - 16384) & 63);
                    *(u32x4*)(base + (size_t)row * 64 + lc) = rope8(acc[ai][0][m][0], acc[ai][0][m][1], cosT, sinT, pos, lc >> 1, 1.f); }
        }
    }
};
struct EpiQ {
    static constexpr bool PERM = true, AFTER_DRAIN = false;
    bf16_t *QN, *QR; const float* cosT; const float* sinT; float sc;
    __device__ __forceinline__ void operator()(const f32x4 (&acc)[2][2][4][2], const Unit& u, int wr, int wc, int fr, int fq) const {
        const int colt = u.pn * BM; const int row0 = u.pm * BM + wr * 64 + fr, lc = wc * 32 + 8 * fq;
        if (colt < 2048) {
#pragma unroll
            for (int ai = 0; ai < 2; ++ai)
#pragma unroll
                for (int m = 0; m < 4; ++m) { bf16_t* rowp = QN + ((size_t)(2 * u.pn) * 16384 + (size_t)(row0 + ai * HALF + m * 16)) * 128 + lc;
#pragma unroll
                    for (int bj = 0; bj < 2; ++bj) *(u32x4*)(rowp + (size_t)bj * 16384 * 128) = pack8s(acc[ai][bj][m][0], acc[ai][bj][m][1], sc); }
        } else {
            const int c0 = colt - 2048;
#pragma unroll
            for (int ai = 0; ai < 2; ++ai)
#pragma unroll
                for (int m = 0; m < 4; ++m) { const int row = row0 + ai * HALF + m * 16; const int pos = 16 + (row & 4095);
#pragma unroll
                    for (int bj = 0; bj < 2; ++bj) { const int cl = c0 + bj * HALF + lc;
                        *(u32x4*)(QR + ((size_t)(cl >> 6) * 16384 + row) * 64 + (cl & 63)) = rope8(acc[ai][bj][m][0], acc[ai][bj][m][1], cosT, sinT, pos, (cl & 63) >> 1, sc); } }
        }
    }
};
struct EpiKV {
    static constexpr bool PERM = true, AFTER_DRAIN = false;
    bf16_t* KVh;
    __device__ __forceinline__ void operator()(const f32x4 (&acc)[2][2][4][2], const Unit& u, int wr, int wc, int fr, int fq) const {
        const int row0 = u.pm * BM + wr * 64 + fr, lc = wc * 32 + 8 * fq;
#pragma unroll
        for (int ai = 0; ai < 2; ++ai)
#pragma unroll
            for (int m = 0; m < 4; ++m) { bf16_t* rowp = KVh + ((size_t)(2 * u.pn) * 16640 + (size_t)(row0 + ai * HALF + m * 16)) * 128 + lc;
#pragma unroll
                for (int bj = 0; bj < 2; ++bj) *(u32x4*)(rowp + (size_t)bj * 16640 * 128) = pack8s(acc[ai][bj][m][0], acc[ai][bj][m][1], 1.f); }
    }
};
struct EpiY {
    static constexpr bool PERM = true, AFTER_DRAIN = false;
    float* Y; int ldc;
    __device__ __forceinline__ void operator()(const f32x4 (&acc)[2][2][4][2], const Unit& u, int wr, int wc, int fr, int fq) const {
        const int row0 = u.pm * BM + wr * 64 + fr, col0 = u.pn * BM + wc * 32 + 8 * fq;
#pragma unroll
        for (int ai = 0; ai < 2; ++ai)
#pragma unroll
            for (int m = 0; m < 4; ++m) { float* rowp = Y + (size_t)(row0 + ai * HALF + m * 16) * ldc + col0;
#pragma unroll
                for (int bj = 0; bj < 2; ++bj) { *(f32x4*)(rowp + bj * HALF) = acc[ai][bj][m][0]; *(f32x4*)(rowp + bj * HALF + 4) = acc[ai][bj][m][1]; } }
    }
};

template <class Epi, class Sched, bool ALIGN_EPI = false, bool SP2 = false>
__device__ __forceinline__ void gemm_phase(PG8_LAS unsigned char* lds, const Gemm g, const Sched& S, const Epi& E, const int wid_arg) {
    const int wid = wid_arg, lane = (int)__builtin_amdgcn_mbcnt_hi(~0u, __builtin_amdgcn_mbcnt_lo(~0u, 0u)), tid = wid * 64 + lane, wr = wid >> 2, wc = wid & 3, fr = lane & 15, fq = lane >> 4;
    const int K = g.K, nt = K / BK;
    unsigned voffA[2], voffB[2];
#pragma unroll
    for (int i = 0; i < 2; ++i) { int R, C; stage_rc(tid * 16 + i * 8192, R, C); const int Rb = Epi::PERM ? ((R & ~31) + perm32(R & 31)) : R;
        voffA[i] = (unsigned)(R * K + C) * 2u; voffB[i] = (unsigned)(Rb * K + C) * 2u; }
    const size_t kstep = (size_t)(BK * 2);
    const size_t hstep = (size_t)HALF * K * 2;
    const size_t tstep = 2 * hstep;
    const unsigned ldsw = (unsigned)wid * 1024u;
    const int aoff = lds_byte(wr * 64 + fr, fq * 8), boff = lds_byte(wc * 32 + fr, fq * 8);
#define PG8_SA(b, h) (((b) * 2 + (h)) * HTB)
#define PG8_SB(b, h) ((4 + (b) * 2 + (h)) * HTB)
#define PG8_STAGE(bufoff, gbase, voff) do { _Pragma("unroll") for (int _i = 0; _i < 2; ++_i) \
        __builtin_amdgcn_global_load_lds((const unsigned*)((const char*)(gbase) + (voff)[_i]), (PG8_LAS unsigned*)(lds + (bufoff) + ldsw + _i * 8192), 16, 0, 0); } while (0)
#define PG8_LDA(dst, b, h) do { _Pragma("unroll") for (int m = 0; m < 4; ++m) _Pragma("unroll") for (int k = 0; k < 2; ++k) dst[m][k] = *(const PG8_LAS bf16x8*)(lds + PG8_SA(b, h) + aoff + m * 2048 + k * 1024); } while (0)
#define PG8_LDB(dst, b, h) do { _Pragma("unroll") for (int n = 0; n < 2; ++n) _Pragma("unroll") for (int k = 0; k < 2; ++k) dst[n][k] = *(const PG8_LAS bf16x8*)(lds + PG8_SB(b, h) + boff + n * 2048 + k * 1024); } while (0)
#define PG8_MMA(ai, bj, At, Bt) do { __builtin_amdgcn_s_setprio(1); _Pragma("unroll") for (int m = 0; m < 4; ++m) _Pragma("unroll") for (int n = 0; n < 2; ++n) _Pragma("unroll") for (int k = 0; k < 2; ++k) \
        acc[ai][bj][m][n] = __builtin_amdgcn_mfma_f32_16x16x32_bf16(Bt[n][k], At[m][k], acc[ai][bj][m][n], 0, 0, 0); __builtin_amdgcn_s_setprio(0); } while (0)
#define PG8_WAIT_V(n) asm volatile("s_waitcnt vmcnt(" #n ")" ::: "memory")
#define PG8_WAIT_L(n) asm volatile("s_waitcnt lgkmcnt(" #n ")" ::: "memory")
#define PG8_BAR __builtin_amdgcn_s_barrier()
#define PG8_SCHED __builtin_amdgcn_sched_barrier(0)
    Unit cur, nxt; int ui = 0;
    if (!S.next(0, cur)) return;
    f32x4 acc[2][2][4][2];
#pragma unroll
    for (int a = 0; a < 2; ++a)
#pragma unroll
        for (int b = 0; b < 2; ++b)
#pragma unroll
            for (int m = 0; m < 4; ++m)
#pragma unroll
                for (int n = 0; n < 2; ++n) acc[a][b][m][n] = (f32x4){0.f, 0.f, 0.f, 0.f};
    bf16x8 At[4][2], B0[2][2], B1[2][2];
    const char* cA = (const char*)g.A + (size_t)cur.pm * tstep; const char* cB = (const char*)g.Bt + (size_t)cur.pn * tstep;
    S.a_ready(cur);
    if constexpr (SP2) {
        PG8_STAGE(PG8_SB(0, 0), cB, voffB); PG8_STAGE(PG8_SB(0, 1), cB + hstep, voffB); PG8_STAGE(PG8_SA(0, 0), cA, voffA); PG8_STAGE(PG8_SA(0, 1), cA + hstep, voffA);
        if (wr == 1) PG8_BAR;
        PG8_WAIT_V(2); PG8_BAR;
        PG8_STAGE(PG8_SB(1, 0), cB + kstep, voffB); PG8_STAGE(PG8_SA(1, 0), cA + kstep, voffA); PG8_STAGE(PG8_SB(1, 1), cB + hstep + kstep, voffB);
        PG8_WAIT_V(6); PG8_BAR;
    } else {
        PG8_STAGE(PG8_SB(0, 0), cB, voffB); PG8_STAGE(PG8_SA(0, 0), cA, voffA); PG8_STAGE(PG8_SB(0, 1), cB + hstep, voffB); PG8_STAGE(PG8_SA(0, 1), cA + hstep, voffA);
        if (wr == 1) PG8_BAR;
        PG8_WAIT_V(4); PG8_BAR;
        PG8_STAGE(PG8_SB(1, 0), cB + kstep, voffB); PG8_STAGE(PG8_SA(1, 0), cA + kstep, voffA); PG8_STAGE(PG8_SB(1, 1), cB + hstep + kstep, voffB);
        PG8_WAIT_V(6); PG8_BAR;
    }
    for (;;) {
        const bool has_next = S.next(ui + 1, nxt);
        const char* nA = has_next ? (const char*)g.A + (size_t)nxt.pm * tstep : cA; const char* nB = has_next ? (const char*)g.Bt + (size_t)nxt.pn * tstep : cB;
        for (int t = 0; t < nt; t += 2) {
            const bool last = (t == nt - 2);
            const char* a1 = cA + (size_t)(t + 1) * kstep;
            const char* a2 = last ? nA : cA + (size_t)(t + 2) * kstep; const char* b2 = last ? nB : cB + (size_t)(t + 2) * kstep;
            const char* a3 = a2 + kstep; const char* b3 = b2 + kstep;
            if (last && has_next) S.a_ready(nxt);
            if constexpr (SP2) {
            PG8_LDB(B0, 0, 0); PG8_LDB(B1, 0, 1); PG8_SCHED; PG8_LDA(At, 0, 0); PG8_STAGE(PG8_SA(1, 1), a1 + hstep, voffA);
            PG8_WAIT_V(8); PG8_WAIT_L(0); PG8_BAR; PG8_MMA(0, 0, At, B0); PG8_MMA(0, 1, At, B1); PG8_BAR; PG8_SCHED;
            PG8_LDA(At, 0, 1); PG8_STAGE(PG8_SB(0, 0), b2, voffB); PG8_STAGE(PG8_SB(0, 1), b2 + hstep, voffB); PG8_STAGE(PG8_SA(0, 0), a2, voffA);
            PG8_WAIT_V(8); PG8_WAIT_L(0); PG8_BAR; PG8_MMA(1, 0, At, B0); PG8_MMA(1, 1, At, B1); PG8_BAR; PG8_SCHED;
            PG8_LDB(B0, 1, 0); PG8_LDB(B1, 1, 1); PG8_SCHED; PG8_LDA(At, 1, 0); PG8_STAGE(PG8_SA(0, 1), a2 + hstep, voffA);
            PG8_WAIT_V(8); PG8_WAIT_L(0); PG8_BAR; PG8_MMA(0, 0, At, B0); PG8_MMA(0, 1, At, B1); PG8_BAR; PG8_SCHED;
            PG8_LDA(At, 1, 1); PG8_STAGE(PG8_SB(1, 0), b3, voffB); PG8_STAGE(PG8_SB(1, 1), b3 + hstep, voffB); PG8_STAGE(PG8_SA(1, 0), a3, voffA);
            PG8_WAIT_V(8); PG8_WAIT_L(0); PG8_BAR; PG8_MMA(1, 0, At, B0); PG8_MMA(1, 1, At, B1); PG8_BAR; PG8_SCHED;
            } else {
            PG8_LDB(B0, 0, 0); PG8_SCHED; PG8_LDA(At, 0, 0); PG8_STAGE(PG8_SA(1, 1), a1 + hstep, voffA);
            PG8_WAIT_L(8); PG8_BAR; PG8_WAIT_L(0); PG8_MMA(0, 0, At, B0); PG8_BAR; PG8_SCHED;
            PG8_LDB(B1, 0, 1); PG8_STAGE(PG8_SB(0, 0), b2, voffB);
            PG8_BAR; PG8_WAIT_L(0); PG8_MMA(0, 1, At, B1); PG8_BAR;
            PG8_LDA(At, 0, 1); PG8_STAGE(PG8_SA(0, 0), a2, voffA);
            PG8_BAR; PG8_WAIT_L(0); PG8_MMA(1, 0, At, B0); PG8_BAR; PG8_SCHED;
            PG8_STAGE(PG8_SB(0, 1), b2 + hstep, voffB);
            PG8_WAIT_V(6); PG8_BAR; PG8_MMA(1, 1, At, B1); PG8_BAR;
            PG8_LDB(B0, 1, 0); PG8_SCHED; PG8_LDA(At, 1, 0); PG8_STAGE(PG8_SA(0, 1), a2 + hstep, voffA);
            PG8_WAIT_L(8); PG8_BAR; PG8_WAIT_L(0); PG8_MMA(0, 0, At, B0); PG8_BAR; PG8_SCHED;
            PG8_LDB(B1, 1, 1); PG8_STAGE(PG8_SB(1, 0), b3, voffB);
            PG8_BAR; PG8_WAIT_L(0); PG8_MMA(0, 1, At, B1); PG8_BAR;
            PG8_LDA(At, 1, 1); PG8_STAGE(PG8_SA(1, 0), a3, voffA);
            PG8_BAR; PG8_WAIT_L(0); PG8_MMA(1, 0, At, B0); PG8_BAR; PG8_SCHED;
            PG8_STAGE(PG8_SB(1, 1), b3 + hstep, voffB);
            PG8_WAIT_V(6); PG8_BAR; PG8_MMA(1, 1, At, B1); PG8_BAR;
            }
        }
        if constexpr (ALIGN_EPI) { if (wr == 0) PG8_BAR; }
        if constexpr (!Epi::AFTER_DRAIN) { E(acc, cur, wr, wc, fr, fq); S.done(cur); }
        if (!has_next) break;
#pragma unroll
        for (int a = 0; a < 2; ++a)
#pragma unroll
            for (int b = 0; b < 2; ++b)
#pragma unroll
                for (int m = 0; m < 4; ++m)
#pragma unroll
                    for (int n = 0; n < 2; ++n) acc[a][b][m][n] = (f32x4){0.f, 0.f, 0.f, 0.f};
        cur = nxt; cA = nA; cB = nB; ++ui;
        if constexpr (ALIGN_EPI) { if (wr == 1) PG8_BAR; }
    }
    PG8_WAIT_V(0);
    if constexpr (!ALIGN_EPI) { if (wr == 0) PG8_BAR; }
    PG8_BAR;
    if constexpr (Epi::AFTER_DRAIN) { E.fused(acc, cur, wr, wc, fr, fq, lds, wid, lane); S.done(cur); }
#undef PG8_SA
#undef PG8_SB
#undef PG8_STAGE
#undef PG8_LDA
#undef PG8_LDB
#undef PG8_MMA
#undef PG8_WAIT_V
#undef PG8_WAIT_L
#undef PG8_BAR
#undef PG8_SCHED
}
}
namespace att {
typedef unsigned short bf16_t;
typedef short bf16x8 __attribute__((ext_vector_type(8)));
typedef short s16x4 __attribute__((ext_vector_type(4)));
typedef float f32x16 __attribute__((ext_vector_type(16)));
typedef float f32x4 __attribute__((ext_vector_type(4)));
typedef unsigned u32x4 __attribute__((ext_vector_type(4)));
constexpr int NW = 8, QBLK = 32, KVBLK = 64, QB = NW * QBLK;
constexpr int SHM_V = KVBLK * 128 * 2, SHM_K = KVBLK * 128 * 2, SHM_K2 = KVBLK * 64 * 2;
constexpr int OFF_V = 0, OFF_K = 2 * SHM_V, OFF_K2 = OFF_K + 2 * SHM_K, OFF_WS = OFF_K2 + 2 * SHM_K2, OFF_Q2 = OFF_WS + NW * 64 * 4, LDS_BYTES = OFF_Q2 + NW * 4096;
constexpr float THR2 = 8.f * 1.4426950408889634f;
#define KSWZ(row, colB) ((row) * 256 + ((colB) ^ (((row) & 7) << 4)))
#define K2SWZ(row, colB) ((row) * 128 + ((colB) ^ ((((row) >> 1) & 7) << 4)))
#define SBAR() __builtin_amdgcn_sched_barrier(0)
__device__ __forceinline__ int v_st(int k, int c) { const int kk = (k & ~0xC) | ((k & 4) << 1) | ((k & 8) >> 1); return ((kk >> 3) * 4 + (c >> 5)) * 512 + ((kk & 7) * 32 + (c & 31)) * 2; }
__device__ __forceinline__ int v_rd_base(int lane) { return ((lane & 3) << 3) | (((lane >> 2) & 3) << 6) | (((lane >> 4) & 1) << 5) | (((lane >> 5) & 1) << 8); }
constexpr int v_rd_off(int d0, int ks, int half) { return d0 * 512 + ks * 4096 + half * 2048; }
__device__ __forceinline__ int crow(int r, int hi) { return (r & 3) + 8 * (r >> 2) + 4 * hi; }
__device__ __forceinline__ unsigned cvtpk(float lo, float hi) { unsigned r; asm volatile("v_cvt_pk_bf16_f32 %0, %1, %2" : "=v"(r) : "v"(lo), "v"(hi)); return r; }

template <bool NAT>
__device__ __forceinline__ void partialSM(f32x16& p0, f32x16& p1, float& m_reg, float& mn, float& alpha) {
    float pmax = p0[0]; for (int r = 1; r < 16; ++r) pmax = fmaxf(pmax, p0[r]); for (int r = 0; r < 16; ++r) pmax = fmaxf(pmax, p1[r]);
    { auto rr = __builtin_amdgcn_permlane32_swap(__float_as_uint(pmax), __float_as_uint(pmax), false, false);
      pmax = fmaxf(__uint_as_float(rr[0]), __uint_as_float(rr[1])); }
    constexpr float C2 = 1.4426950408889634f;
    if constexpr (NAT) {
        if (__builtin_expect(__all((pmax - m_reg) <= 8.f), 1)) { mn = m_reg; alpha = 1.f; }
        else { mn = fmaxf(m_reg, pmax); alpha = __builtin_amdgcn_exp2f((m_reg - mn) * C2); m_reg = mn; }
        const float mnL = -mn * C2;
        for (int r = 0; r < 16; ++r) p0[r] = fmaf(p0[r], C2, mnL); for (int r = 0; r < 16; ++r) p1[r] = fmaf(p1[r], C2, mnL);
    } else {
        if (__builtin_expect(__all((pmax - m_reg) <= THR2), 1)) { mn = m_reg; alpha = 1.f; }
        else { mn = fmaxf(m_reg, pmax); alpha = __builtin_amdgcn_exp2f(m_reg - mn); m_reg = mn; }
        for (int r = 0; r < 16; ++r) p0[r] = p0[r] - mn; for (int r = 0; r < 16; ++r) p1[r] = p1[r] - mn;
    }
    for (int r = 0; r < 16; ++r) p0[r] = __builtin_amdgcn_exp2f(p0[r]);
}
__device__ __forceinline__ void finishSM(f32x16& p0, f32x16& p1, float alpha, float& l_reg, bf16x8& pa0, bf16x8& pa1, bf16x8& pa2, bf16x8& pa3) {
    for (int r = 0; r < 16; ++r) p1[r] = __builtin_amdgcn_exp2f(p1[r]);
    float ps = 0; for (int r = 0; r < 16; ++r) ps += p0[r]; for (int r = 0; r < 16; ++r) ps += p1[r];
    { auto rr = __builtin_amdgcn_permlane32_swap(__float_as_uint(ps), __float_as_uint(ps), false, false);
      ps = __uint_as_float(rr[0]) + __uint_as_float(rr[1]); }
    l_reg = l_reg * alpha + ps;
#define PK4(P, B_, OUT) do { unsigned a0 = cvtpk(P[B_+0], P[B_+1]), a1 = cvtpk(P[B_+2], P[B_+3]);                          \
        unsigned b0 = cvtpk(P[B_+4], P[B_+5]), b1 = cvtpk(P[B_+6], P[B_+7]);                                             \
        auto r0 = __builtin_amdgcn_permlane32_swap(a0, b0, false, false); auto r1 = __builtin_amdgcn_permlane32_swap(a1, b1, false, false); \
        u32x4 w = {r0[0], r1[0], r0[1], r1[1]}; OUT = *reinterpret_cast<bf16x8*>(&w); } while (0)
    PK4(p0, 0, pa0); PK4(p0, 8, pa1); PK4(p1, 0, pa2); PK4(p1, 8, pa3);
#undef PK4
}
template <int KB, bool ROPE, bool AUG, bool QLDS = false>
__device__ __forceinline__ void qkt(f32x16& p0, f32x16& p1, const char* K_lds, const char* K2_lds, int r32, int hi, const bf16x8* qr, const char* q2l, bf16x8 ka0, bf16x8 ka1, bf16x8 qa) {
    p0 = f32x16{}; p1 = f32x16{};
    const char* kb[4];
#pragma unroll
    for (int dd = 0; dd < 4; ++dd) kb[dd] = K_lds + KB * SHM_K + KSWZ(r32, (dd * 16 + hi * 8) * 2);
#pragma unroll
    for (int d0 = 0; d0 < 8; ++d0) { const char* a = kb[d0 & 3] + (d0 >> 2) * 128;
        bf16x8 b0 = *reinterpret_cast<const bf16x8*>(a);
        bf16x8 b1 = *reinterpret_cast<const bf16x8*>(a + 32 * 256);
        bf16x8 qf; if (QLDS && d0 >= 6) qf = *reinterpret_cast<const bf16x8*>(q2l + (d0 - 6) * 1024); else qf = qr[d0];
        p0 = __builtin_amdgcn_mfma_f32_32x32x16_bf16(b0, qf, p0, 0, 0, 0);
        p1 = __builtin_amdgcn_mfma_f32_32x32x16_bf16(b1, qf, p1, 0, 0, 0); }
    if constexpr (ROPE) {
#pragma unroll
        for (int e = 0; e < 4; ++e) { const char* a = K2_lds + KB * SHM_K2 + K2SWZ(r32, (e * 2 + hi) * 16);
            bf16x8 b0 = *reinterpret_cast<const bf16x8*>(a);
            bf16x8 b1 = *reinterpret_cast<const bf16x8*>(a + 32 * 128);
            const bf16x8 q2 = *reinterpret_cast<const bf16x8*>(q2l + e * 1024);
            p0 = __builtin_amdgcn_mfma_f32_32x32x16_bf16(b0, q2, p0, 0, 0, 0);
            p1 = __builtin_amdgcn_mfma_f32_32x32x16_bf16(b1, q2, p1, 0, 0, 0); }
    }
    if constexpr (AUG) {
        p0 = __builtin_amdgcn_mfma_f32_32x32x16_bf16(ka0, qa, p0, 0, 0, 0);
        p1 = __builtin_amdgcn_mfma_f32_32x32x16_bf16(ka1, qa, p1, 0, 0, 0); }
}
template <int VB>
__device__ __forceinline__ void pv_tile(f32x16* o, int vb0, bf16x8 pa0, bf16x8 pa1, bf16x8 pa2, bf16x8 pa3) {
#define TRRD(dst, off) asm volatile("ds_read_b64_tr_b16 %0, %1 offset:%2" : "=&v"(dst) : "v"(vb0), "i"(off) : "memory")
#define PV_D0(d0) do { s16x4 l0, l1, l2, l3, h0, h1, h2, h3; constexpr int b_ = VB * SHM_V + v_rd_off(d0, 0, 0); \
        TRRD(l0, b_); TRRD(h0, b_ + 2048); TRRD(l1, b_ + 4096); TRRD(h1, b_ + 6144); TRRD(l2, b_ + 8192); TRRD(h2, b_ + 10240); TRRD(l3, b_ + 12288); TRRD(h3, b_ + 14336); \
        asm volatile("s_waitcnt lgkmcnt(0)" ::: "memory"); SBAR();   \
        o[d0] = __builtin_amdgcn_mfma_f32_32x32x16_bf16(pa0, (bf16x8){l0[0], l0[1], l0[2], l0[3], h0[0], h0[1], h0[2], h0[3]}, o[d0], 0, 0, 0);   \
        o[d0] = __builtin_amdgcn_mfma_f32_32x32x16_bf16(pa1, (bf16x8){l1[0], l1[1], l1[2], l1[3], h1[0], h1[1], h1[2], h1[3]}, o[d0], 0, 0, 0);   \
        o[d0] = __builtin_amdgcn_mfma_f32_32x32x16_bf16(pa2, (bf16x8){l2[0], l2[1], l2[2], l2[3], h2[0], h2[1], h2[2], h2[3]}, o[d0], 0, 0, 0);   \
        o[d0] = __builtin_amdgcn_mfma_f32_32x32x16_bf16(pa3, (bf16x8){l3[0], l3[1], l3[2], l3[3], h3[0], h3[1], h3[2], h3[3]}, o[d0], 0, 0, 0); } while (0)
    PV_D0(0); PV_D0(1); PV_D0(2); PV_D0(3);
#undef PV_D0
#undef TRRD
}
template <int OP>
__device__ __forceinline__ void store_o_tile(const f32x16* o, const float* rli, char* stg, bf16_t* Ow, int r32e, int hie, int lane2) {
#pragma unroll
    for (int hf = 0; hf < 2; ++hf) {
#pragma unroll
        for (int r = 0; r < 16; ++r) { const int orow = crow(r, hie);
#pragma unroll
            for (int d = 0; d < 2; ++d) { const float v = o[2 * hf + d][r] * rli[r]; *(unsigned short*)(stg + (orow * 64 + d * 32 + r32e) * 2) = (unsigned short)cvtpk(v, v); } }
        asm volatile("s_waitcnt lgkmcnt(0)" ::: "memory");
#pragma unroll
        for (int i = 0; i < 4; ++i) { const int row = i * 8 + (lane2 >> 3), ch = lane2 & 7; const u32x4 w = *(const u32x4*)(stg + (row * 64 + ch * 8) * 2);
            *(u32x4*)(Ow + (size_t)row * OP + hf * 64 + ch * 8) = w; }
        asm volatile("s_waitcnt lgkmcnt(0)" ::: "memory"); }
}
struct Unit {
    const bf16_t* Q;
    const bf16_t* Q2;
    const bf16_t* Kr; const bf16_t* Km;
    const bf16_t* K2r; const bf16_t* K2m;
    const bf16_t* Vr; const bf16_t* Vm;
    bf16_t* O;
    int qb; float nslope2;
    const float* kn2; const float* qst;
};
template <bool ROPE, bool ALIBI, int QP, int Q2P, int KP, int VP, int OP>
__device__ __forceinline__ void attn_unit(const Unit& u, char* lds, const int wid) {
    int lane; asm volatile("v_mbcnt_lo_u32_b32 %0, -1, 0\n\tv_mbcnt_hi_u32_b32 %0, -1, %0" : "=v"(lane));
    const int tid = wid * 64 + lane, r32 = lane & 31, hi = lane >> 5;
    int toff = 0;
    if constexpr (ALIBI) {
        const float* qs = u.qst + (4 * u.qb) * 2;
        const float qn2 = fmaxf(fmaxf(qs[0], qs[2]), fmaxf(qs[4], qs[6])), mlb = fminf(fminf(qs[1], qs[3]), fminf(qs[5], qs[7]));
        const int t = lane + 1, dmin = 256 * u.qb - 64 * t + 1;
        const bool inr = t < 4 * u.qb + 5 && dmin > 0;
        const float kn2v = inr ? u.kn2[t] : 0.f;
        const float ub = sqrtf(qn2 * kn2v) * 1.001f + 0.01f + u.nslope2 * (float)dmin;
        const unsigned long long bal = __ballot(inr && ub < mlb - 115.f);
        const int t_lo = 1 + __builtin_ctzll(~bal);
        toff = __builtin_amdgcn_readfirstlane((t_lo - 1) & ~1);
    }
    const int NT = 4 * u.qb + 5 - toff;
    const int jq = 1 + 4 * u.qb + (wid >> 1);
    char* V_lds = lds + OFF_V; char* K_lds = lds + OFF_K; char* K2_lds = lds + OFF_K2;
    float* ws = (float*)(lds + OFF_WS) + wid * 64; float* li_l = ws, * al_l = ws + 32;
    float m_reg = -1e30f, l_reg = 0; f32x16 o[4] = {};
    const int sr = tid >> 4, sc = (tid & 15) * 8, vst0 = v_st(sr, sc), vst1 = v_st(32 + sr, sc), kws = KSWZ(sr, sc * 2);
    const int sr2 = tid >> 3, sc2 = (tid & 7) * 8, k2ws = K2SWZ(sr2, sc2 * 2);
    const int vb0 = (int)(uintptr_t)V_lds + v_rd_base(lane);
    const unsigned vo0 = (unsigned)(sr * VP + sc) * 2u, vo1 = (unsigned)((32 + sr) * VP + sc) * 2u, ko0 = (unsigned)(sr * KP + sc) * 2u, ko1 = (unsigned)((32 + sr) * KP + sc) * 2u, k2o = (unsigned)(sr2 * 64 + sc2) * 2u;
    bf16x8 st_v0, st_v1, st_k0, st_k1, st_k2;
    bf16x8 qr[8]; const char* q2l = lds + OFF_Q2 + wid * 4096 + lane * 16;
#pragma unroll
    for (int d0 = 0; d0 < 8; ++d0) { const bf16x8 qv = *(const bf16x8*)(u.Q + (size_t)(wid * QBLK + r32) * QP + d0 * 16 + hi * 8);
        if (ALIBI && d0 >= 6) *(bf16x8*)(lds + OFF_Q2 + wid * 4096 + lane * 16 + (d0 - 6) * 1024) = qv; else qr[d0] = qv; }
    if constexpr (ROPE) {
#pragma unroll
        for (int e = 0; e < 4; ++e) *(bf16x8*)(lds + OFF_Q2 + wid * 4096 + lane * 16 + e * 1024) = *(const bf16x8*)(u.Q2 + (size_t)(wid * QBLK + r32) * Q2P + e * 16 + hi * 8);
    }
#define KT(t) ((t) == 0 ? u.Km : u.Kr + (size_t)(64 * ((t) + toff - 1)) * KP)
#define VT(t) ((t) == 0 ? u.Vm : u.Vr + (size_t)(64 * ((t) + toff - 1)) * VP)
#define K2T(t) ((t) == 0 ? u.K2m : u.K2r + (size_t)(64 * ((t) + toff - 1)) * 64)
#define VMW() asm volatile("s_waitcnt vmcnt(0)" ::: "memory")
#define SLOAD(t) do { const char* kt_ = (const char*)(KT(t)); const char* vt_ = (const char*)(VT(t));                         \
        st_v0 = *(const bf16x8*)(vt_ + vo0); st_v1 = *(const bf16x8*)(vt_ + vo1);                                               \
        st_k0 = *(const bf16x8*)(kt_ + ko0); st_k1 = *(const bf16x8*)(kt_ + ko1);                                               \
        if constexpr (ROPE) { st_k2 = *(const bf16x8*)((const char*)(K2T(t)) + k2o); } } while (0)
#define SWRITE_K(bf) do { *(bf16x8*)(K_lds + (bf) * SHM_K + kws) = st_k0; *(bf16x8*)(K_lds + (bf) * SHM_K + kws + 32 * 256) = st_k1;  \
        if constexpr (ROPE) { *(bf16x8*)(K2_lds + (bf) * SHM_K2 + k2ws) = st_k2; } } while (0)
#define SWRITE_V(bf) do { *(bf16x8*)(V_lds + (bf) * SHM_V + vst0) = st_v0; *(bf16x8*)(V_lds + (bf) * SHM_V + vst1) = st_v1; } while (0)
#define SWRITE(bf) do { SWRITE_V(bf); SWRITE_K(bf); } while (0)
#define RESC(a) do { if (__any((a) < 1.f)) { if (hi == 0) al_l[r32] = (a); asm volatile("s_waitcnt lgkmcnt(0)" ::: "memory");              \
                     for (int d_ = 0; d_ < 4; ++d_) for (int r = 0; r < 16; ++r) o[d_][r] *= al_l[crow(r, hi)]; } } while (0)
#define ACT(t) ((t) + toff <= jq)
    bf16x8 qa = {0, 0, 0, 0, 0, 0, 0, 0}; float n2s = 0.f;
    if constexpr (ALIBI) { const float sl = -u.nslope2;
        if (hi == 0) { const unsigned w0 = (__float_as_uint(64.f * sl) >> 16) | (__float_as_uint(sl) & 0xffff0000u), w1 = __float_as_uint(16.f * sl) >> 16;
            const u32x4 qw = {w0, w1, 0u, 0u}; qa = __builtin_bit_cast(bf16x8, qw);
            }
        n2s = -2.f * sl; }
#define KAUG(t, KA0, KA1) bf16x8 KA0 = {0, 0, 0, 0, 0, 0, 0, 0}, KA1 = KA0; if constexpr (ALIBI) { const int J_ = (t) == 0 ? -4 * u.qb : (t) + toff - 1 - 4 * u.qb;      \
        const unsigned jb_ = hi == 0 ? (__float_as_uint((float)J_) >> 16) : 0u, e3_ = (hi == 0 && (t) == 0) ? 0xbf80u : 0u;                                   \
        const unsigned cw0_ = hi == 0 ? (__float_as_uint((float)r32) & 0xffff0000u) : 0u, cw1_ = hi == 0 ? (__float_as_uint((float)(r32 + 32)) & 0xffff0000u) : 0u; \
        const u32x4 k0_ = {jb_ | cw0_, e3_, 0u, 0u}, k1_ = {jb_ | cw1_, e3_, 0u, 0u}; KA0 = __builtin_bit_cast(bf16x8, k0_); KA1 = __builtin_bit_cast(bf16x8, k1_); }
#define BIAS(P0_, P1_, t) do { if (!ACT(t)) { const float NEG_ = -__builtin_inff(); _Pragma("unroll") for (int r = 0; r < 16; ++r) { P0_[r] = NEG_; P1_[r] = NEG_; } }  \
      else if constexpr (ALIBI) { if ((t) + toff == jq) { float dqc = (float)(32 * (wid & 1) + r32 - 4 * hi); asm volatile("" : "+v"(dqc));                                                 \
        _Pragma("unroll") for (int r = 0; r < 16; ++r) { const float c_ = (float)((r & 3) + 8 * (r >> 2));                                                      \
            P0_[r] = fmaf(n2s, fmaxf(c_ - dqc, 0.f), P0_[r]); P1_[r] = fmaf(n2s, fmaxf(c_ + 32.f - dqc, 0.f), P1_[r]); } } } } while (0)
    f32x16 pA0, pA1, pB0, pB1; float mnA, mnB, alA, alB; bf16x8 pa0, pa1, pa2, pa3;
    SLOAD(0); VMW(); SWRITE(0); SBAR();
    SLOAD(1);
    __syncthreads();
    SBAR(); { KAUG(0, ka0_, ka1_); qkt<0, ROPE, ALIBI, ALIBI>(pA0, pA1, K_lds, K2_lds, r32, hi, qr, q2l, ka0_, ka1_, qa); }
    { const float NEG = -__builtin_inff();
#pragma unroll
      for (int r = 8; r < 16; ++r) pA0[r] = NEG;
#pragma unroll
      for (int r = 0; r < 16; ++r) pA1[r] = NEG; }
    BIAS(pA0, pA1, 0); partialSM<ALIBI>(pA0, pA1, m_reg, mnA, alA);
    VMW(); SWRITE(1);
    __syncthreads();
#define HALF_STEP(PX0, PX1, mnX, alX, PY0, PY1, alY, t, KB, VB, SB) do {                                                      \
        SBAR(); { KAUG(t, ka0_, ka1_); qkt<KB, ROPE, ALIBI, ALIBI>(PX0, PX1, K_lds, K2_lds, r32, hi, qr, q2l, ka0_, ka1_, qa); }             \
        finishSM(PY0, PY1, alY, l_reg, pa0, pa1, pa2, pa3); SBAR();                                                           \
        if ((t) + 1 < NT) { SLOAD((t) + 1); SBAR(); }                                                                         \
        pv_tile<VB>(o, vb0, pa0, pa1, pa2, pa3); BIAS(PX0, PX1, (t)); partialSM<ALIBI>(PX0, PX1, m_reg, mnX, alX);    \
        __syncthreads();                                                                                                      \
        if ((t) + 1 < NT) { VMW(); SWRITE(SB); }                                                                              \
        RESC(alX); __syncthreads(); } while (0)
    for (int t = 1; t + 1 < NT; t += 2) {
        HALF_STEP(pB0, pB1, mnB, alB, pA0, pA1, alA, t, 1, 0, 0);
        HALF_STEP(pA0, pA1, mnA, alA, pB0, pB1, alB, t + 1, 0, 1, 1);
    }
    finishSM(pA0, pA1, alA, l_reg, pa0, pa1, pa2, pa3); SBAR();
    pv_tile<0>(o, vb0, pa0, pa1, pa2, pa3);
    int lane2; asm volatile("v_mbcnt_lo_u32_b32 %0, -1, 0\n\tv_mbcnt_hi_u32_b32 %0, -1, %0" : "=v"(lane2));
    const int r32e = lane2 & 31, hie = lane2 >> 5;
    if (hie == 0) li_l[r32e] = l_reg; asm volatile("s_waitcnt lgkmcnt(0)" ::: "memory");
    float rli[16];
#pragma unroll
    for (int r = 0; r < 16; ++r) rli[r] = __builtin_amdgcn_rcpf(li_l[crow(r, hie)]);
    store_o_tile<OP>(o, rli, lds + OFF_K + wid * 4096, u.O + (size_t)(wid * QBLK) * OP, r32e, hie, lane2);
    __syncthreads();
#undef KT
#undef VT
#undef K2T
#undef VMW
#undef SLOAD
#undef SWRITE_K
#undef SWRITE_V
#undef SWRITE
#undef RESC
#undef ACT
#undef BIAS
#undef KAUG
#undef HALF_STEP
}
typedef __attribute__((address_space(1))) const char* gcptr;
__device__ __forceinline__ gcptr sgpr_ptr(const char* p) {
    const unsigned long long v = (unsigned long long)p; const unsigned lo = (unsigned)__builtin_amdgcn_readfirstlane((int)(unsigned)v), hi = (unsigned)__builtin_amdgcn_readfirstlane((int)(unsigned)(v >> 32));
    return (gcptr)(((unsigned long long)hi << 32) | lo); }
struct UnitX {
    const bf16_t* Q;
    const bf16_t* Kr; const bf16_t* Km;
    const bf16_t* V0r; const bf16_t* V0m; const bf16_t* V1r; const bf16_t* V1m;
    bf16_t* O;
    int qb; float nslope;
    const float* kn2; const float* qst;
};
constexpr int XOFF_V = 0, XOFF_K = 65536, XOFF_P = 98304, XOFF_WS = 131072, XOFF_PS = XOFF_WS + 2048, XLDS_BYTES = XOFF_PS + 2048;
template <int OP>
__device__ __forceinline__ void attn_unit_x(const UnitX& u, char* lds, const int wid) {
    int lane; asm volatile("v_mbcnt_lo_u32_b32 %0, -1, 0\n\tv_mbcnt_hi_u32_b32 %0, -1, %0" : "=v"(lane));
    const int tid = wid * 64 + lane, r32 = lane & 31, hi = lane >> 5, g = wid & 3, vh = wid >> 2;
    int toff = 0;
    { const float* qs = u.qst + (2 * u.qb) * 2;
      const float qn2 = fmaxf(qs[0], qs[2]), mlb = fminf(qs[1], qs[3]);
      const int t = lane + 1, dmin = 128 * u.qb - 64 * t + 1;
      const bool inr = t < 2 * u.qb + 3 && dmin > 0;
      const float kn2v = inr ? u.kn2[t] : 0.f;
      float k1_ = 1.001f, k2_ = 115.01f; asm volatile("" : "+v"(k1_), "+v"(k2_));
      const float ub = sqrtf(qn2 * kn2v) * k1_ + u.nslope * (float)dmin;
      const unsigned long long bal = __ballot(inr && ub < mlb - k2_);
      const int t_lo = 1 + __builtin_ctzll(~bal);
      toff = __builtin_amdgcn_readfirstlane((t_lo - 1) & ~1); }
    const int NT = 2 * u.qb + 3 - toff;
    const int jq = 1 + 2 * u.qb + (g >> 1);
    char* K_lds = lds + XOFF_K; char* Vh_lds = lds + XOFF_V + vh * 32768;
    char* pbuf = lds + XOFF_P + g * 8192 + lane * 16;
    float* psc = (float*)(lds + XOFF_PS) + g * 128;
    float l_reg = 0.f; f32x16 o[4] = {};
    const int sr = tid >> 4, sc = (tid & 15) * 8, vst0 = v_st(sr, sc), vst1 = v_st(32 + sr, sc), kws = KSWZ(sr, sc * 2);
    const int vb0 = (int)(uintptr_t)Vh_lds + v_rd_base(lane);
    const unsigned so0 = (unsigned)(sr * 128 + sc) * 2u, so1 = (unsigned)((32 + sr) * 128 + sc) * 2u;
    bf16x8 st_k0, st_k1, st_a0, st_a1, st_b0, st_b1;
    bf16x8 qr[8];
#pragma unroll
    for (int d0 = 0; d0 < 8; ++d0) qr[d0] = *(const bf16x8*)(u.Q + (size_t)(g * QBLK + r32) * 128 + d0 * 16 + hi * 8);
    unsigned qw0s, qw1s; float n2s;
    { const float sl = -u.nslope;
      qw0s = (unsigned)__builtin_amdgcn_readfirstlane((int)((__float_as_uint(64.f * sl) >> 16) | (__float_as_uint(sl) & 0xffff0000u)));
      qw1s = (unsigned)__builtin_amdgcn_readfirstlane((int)(__float_as_uint(16.f * sl) >> 16)); n2s = -2.f * sl; }
#define XKT(t) ((const char*)((t) == 0 ? u.Km : u.Kr + (size_t)(64 * ((t) + toff - 1)) * 128))
#define XV0T(t) ((const char*)((t) == 0 ? u.V0m : u.V0r + (size_t)(64 * ((t) + toff - 1)) * 128))
#define XV1T(t) ((const char*)((t) == 0 ? u.V1m : u.V1r + (size_t)(64 * ((t) + toff - 1)) * 128))
#define XVMW() asm volatile("s_waitcnt vmcnt(0)" ::: "memory")
#define XLOAD_K(t) do { const gcptr p_ = sgpr_ptr(XKT(t)); st_k0 = *(const __attribute__((address_space(1))) bf16x8*)(p_ + so0); st_k1 = *(const __attribute__((address_space(1))) bf16x8*)(p_ + so1); } while (0)
#define XLOAD_V(t) do { const gcptr a_ = sgpr_ptr(XV0T(t)); const gcptr b_ = sgpr_ptr(XV1T(t)); st_a0 = *(const __attribute__((address_space(1))) bf16x8*)(a_ + so0); st_a1 = *(const __attribute__((address_space(1))) bf16x8*)(a_ + so1); st_b0 = *(const __attribute__((address_space(1))) bf16x8*)(b_ + so0); st_b1 = *(const __attribute__((address_space(1))) bf16x8*)(b_ + so1); } while (0)
#define XWRITE_K(bf) do { *(bf16x8*)(K_lds + (bf) * SHM_K + kws) = st_k0; *(bf16x8*)(K_lds + (bf) * SHM_K + kws + 32 * 256) = st_k1; } while (0)
#define XWRITE_V(bf) do { *(bf16x8*)(lds + XOFF_V + (bf) * SHM_V + vst0) = st_a0; *(bf16x8*)(lds + XOFF_V + (bf) * SHM_V + vst1) = st_a1;             \
        *(bf16x8*)(lds + XOFF_V + 32768 + (bf) * SHM_V + vst0) = st_b0; *(bf16x8*)(lds + XOFF_V + 32768 + (bf) * SHM_V + vst1) = st_b1; } while (0)
#define XACT(t) ((t) + toff <= jq)
#define XKAUG(t, KA0, KA1, QA) bf16x8 KA0, KA1, QA; { int hz_ = hi; asm volatile("" : "+v"(hz_));                                                       \
        const u32x4 qw_ = {hz_ == 0 ? qw0s : 0u, hz_ == 0 ? qw1s : 0u, 0u, 0u}; QA = __builtin_bit_cast(bf16x8, qw_);                                   \
        const int J_ = (t) == 0 ? -2 * u.qb : (t) + toff - 1 - 2 * u.qb;                                                                                \
        const unsigned jb_ = hz_ == 0 ? (__float_as_uint((float)J_) >> 16) : 0u, e3_ = (hz_ == 0 && (t) == 0) ? 0xbf80u : 0u;                            \
        const unsigned cw0_ = hz_ == 0 ? (__float_as_uint((float)r32) & 0xffff0000u) : 0u, cw1_ = hz_ == 0 ? (__float_as_uint((float)(r32 + 32)) & 0xffff0000u) : 0u; \
        const u32x4 k0_ = {jb_ | cw0_, e3_, 0u, 0u}, k1_ = {jb_ | cw1_, e3_, 0u, 0u}; KA0 = __builtin_bit_cast(bf16x8, k0_); KA1 = __builtin_bit_cast(bf16x8, k1_); }
#define XQKT(t, KB) do { XKAUG(t, ka0_, ka1_, qa_); qkt<KB, false, true>(S0, S1, K_lds, nullptr, r32, hi, qr, nullptr, ka0_, ka1_, qa_); } while (0)
#define XSM(t, PB) do {                                                                                                                                  \
        if ((t) == 0) { const float NEG_ = -__builtin_inff(); _Pragma("unroll") for (int r = 8; r < 16; ++r) S0[r] = NEG_; _Pragma("unroll") for (int r = 0; r < 16; ++r) S1[r] = NEG_; } \
        if (!XACT(t)) { const float NEG_ = -__builtin_inff(); _Pragma("unroll") for (int r = 0; r < 16; ++r) { S0[r] = NEG_; S1[r] = NEG_; } }           \
        else if ((t) + toff == jq) { float dqc = (float)(32 * (g & 1) + r32 - 4 * hi), n2x = n2s; asm volatile("" : "+v"(dqc), "+v"(n2x));              \
            _Pragma("unroll") for (int r = 0; r < 16; ++r) { const float c_ = (float)((r & 3) + 8 * (r >> 2));                                           \
                S0[r] = fmaf(n2x, fmaxf(c_ - dqc, 0.f), S0[r]); S1[r] = fmaf(n2x, fmaxf(c_ + 32.f - dqc, 0.f), S1[r]); } }                                \
        float m_ = (t) == 0 ? -1e30f : psc[(1 - (PB)) * 64 + 32 + r32]; float mn_, al_;                                                                  \
        partialSM<true>(S0, S1, m_, mn_, al_); finishSM(S0, S1, al_, l_reg, pa0, pa1, pa2, pa3); alpha = al_;                                           \
        if (hi == 0) { psc[(PB) * 64 + r32] = al_; psc[(PB) * 64 + 32 + r32] = mn_; }                                                                   \
        *(bf16x8*)(pbuf + (PB) * 4096) = pa0; *(bf16x8*)(pbuf + (PB) * 4096 + 1024) = pa1; *(bf16x8*)(pbuf + (PB) * 4096 + 2048) = pa2; *(bf16x8*)(pbuf + (PB) * 4096 + 3072) = pa3; } while (0)
#define XPV(t, PB, VB, OWN) do {                                                                                                                          \
        if (!(OWN)) { alpha = psc[(PB) * 64 + r32]; l_reg *= alpha;                                                                                      \
            pa0 = *(const bf16x8*)(pbuf + (PB) * 4096); pa1 = *(const bf16x8*)(pbuf + (PB) * 4096 + 1024); pa2 = *(const bf16x8*)(pbuf + (PB) * 4096 + 2048); pa3 = *(const bf16x8*)(pbuf + (PB) * 4096 + 3072); } \
        if (__any(alpha < 1.f)) { asm volatile("s_waitcnt lgkmcnt(0)" ::: "memory");                                                                      \
            for (int d_ = 0; d_ < 4; ++d_) for (int r = 0; r < 16; ++r) o[d_][r] *= psc[(PB) * 64 + crow(r, hi)]; }                                      \
        if (XACT(t)) pv_tile<VB>(o, vb0, pa0, pa1, pa2, pa3); } while (0)
    f32x16 S0, S1; bf16x8 pa0, pa1, pa2, pa3; float alpha = 1.f;
    { XLOAD_K(1); const bf16x8 n0_ = st_k0, n1_ = st_k1;
      XLOAD_K(0); XLOAD_V(0); XVMW(); XWRITE_K(0); XWRITE_V(0);
      *(bf16x8*)(K_lds + SHM_K + kws) = n0_; *(bf16x8*)(K_lds + SHM_K + kws + 32 * 256) = n1_; }
    __syncthreads();
    if (vh == 0) XQKT(0, 0);
#define XSTEP(t, PB, KBN, VBT, LAST) do {                                                                                                                 \
        const bool own_ = (((t) & 1) == vh);                                                                                                            \
        if (!(LAST)) { if ((t) + 2 < NT) XLOAD_K((t) + 2); XLOAD_V((t) + 1); }                                                                           \
        SBAR();                                                                                                                                          \
        if (own_) { XSM(t, PB); } else if (!(LAST)) { XQKT((t) + 1, KBN); }                                                                              \
        asm volatile("s_waitcnt lgkmcnt(0)" ::: "memory"); __syncthreads();                                                                              \
        if (!(LAST)) { XVMW(); if ((t) + 2 < NT) XWRITE_K(PB); XWRITE_V(1 - (PB)); }                                                                      \
        XPV(t, PB, VBT, own_);                                                                                                                            \
        asm volatile("s_waitcnt lgkmcnt(0)" ::: "memory"); __syncthreads(); } while (0)
    int t = 0;
    for (; t + 1 < NT; t += 2) {
        XSTEP(t, 0, 1, 0, false);
        XSTEP(t + 1, 1, 0, 1, false);
    }
    XSTEP(NT - 1, 0, 1, 0, true);
    int lane2; asm volatile("v_mbcnt_lo_u32_b32 %0, -1, 0\n\tv_mbcnt_hi_u32_b32 %0, -1, %0" : "=v"(lane2));
    const int r32e = lane2 & 31, hie = lane2 >> 5;
    if (hie == 0) psc[vh * 64 + r32e] = l_reg;
    asm volatile("s_waitcnt lgkmcnt(0)" ::: "memory"); __syncthreads();
    float rli[16];
#pragma unroll
    for (int r = 0; r < 16; ++r) rli[r] = __builtin_amdgcn_rcpf(psc[crow(r, hie)] + psc[64 + crow(r, hie)]);
    store_o_tile<OP>(o, rli, lds + XOFF_K + wid * 4096, u.O + (size_t)(g * QBLK) * OP + vh * 128, r32e, hie, lane2);
    asm volatile("s_waitcnt lgkmcnt(0)" ::: "memory"); __syncthreads();
#undef XKT
#undef XV0T
#undef XV1T
#undef XVMW
#undef XLOAD_K
#undef XLOAD_V
#undef XWRITE_K
#undef XWRITE_V
#undef XACT
#undef XKAUG
#undef XQKT
#undef XSM
#undef XPV
#undef XSTEP
}
#undef KSWZ
#undef K2SWZ
#undef SBAR
}

constexpr int NWAVES = 8;
constexpr int D_MODEL = 4096, BATCH = 4, SEQ = 4096, N_META = 16;
constexpr int MR = BATCH * SEQ;
constexpr int MP = MR + 256;
constexpr int NIN = 12544;
constexpr int Q_LORA = 1536, KV_LORA = 512;
constexpr float RMS_EPS = 1e-6f, LOG2E = 1.4426950408889634f;
constexpr float LAMBDA_INIT = 0.2f;
constexpr size_t MiB = 1u << 20;
constexpr size_t WS_WIN = 0;
constexpr size_t WS_O1 = 0;
constexpr size_t WS_WUQ = 98 * MiB;
constexpr size_t WS_WUKV = 107 * MiB;
constexpr size_t WS_WOUT = 111 * MiB;
constexpr size_t WS_TAB = 143 * MiB;
constexpr size_t WS_XN = 145 * MiB;
constexpr size_t WS_QD = 275 * MiB, WS_KD = 340 * MiB, WS_VD = 405 * MiB, WS_GD = 470 * MiB;
constexpr size_t WS_CQ = 535 * MiB;
constexpr size_t WS_CKV = WS_CQ + (size_t)MP * Q_LORA * 2;
constexpr size_t WS_O2 = WS_CQ;
constexpr size_t WS_GM = 600 * MiB;
constexpr size_t WS_KR = 665 * MiB;
constexpr size_t WS_QN = 668 * MiB;
constexpr size_t WS_QR = 733 * MiB;
constexpr size_t WS_KV = 766 * MiB;
constexpr size_t WS_OB = 896 * MiB;
constexpr size_t WS_CTL = 961 * MiB, CTL_ZERO_BYTES = 16384;
constexpr size_t WS_END = 962 * MiB;
static_assert(WS_CKV + (size_t)MP * KV_LORA * 2 <= WS_GM && (size_t)NIN * 4096 * 2 <= WS_WUQ && WS_XN + (size_t)MP * 4096 * 2 <= WS_QD, "d_ws map");
constexpr int RING_BYTES = 135168, LDSCTL_OFF = RING_BYTES, MISC_OFF = LDSCTL_OFF + 320, LDS_BYTES = 147456;
static_assert(att::LDS_BYTES <= RING_BYTES && att::XLDS_BYTES <= RING_BYTES, "attention LDS");
#define LAS __attribute__((address_space(3)))
#define GAS __attribute__((address_space(1)))
#define RLX_AGENT __ATOMIC_RELAXED, __HIP_MEMORY_SCOPE_AGENT
typedef unsigned short bf16;
typedef unsigned v4u __attribute__((ext_vector_type(4)));
typedef float f32x4 __attribute__((ext_vector_type(4)));
#define LDS_WAIT() asm volatile("s_waitcnt lgkmcnt(0)" ::: "memory")
__device__ __forceinline__ unsigned f2bf(float f) { unsigned u = __builtin_bit_cast(unsigned, f); return (u + 0x7fffu + ((u >> 16) & 1u)) >> 16; }
__device__ __forceinline__ unsigned pk2(float lo, float hi) { return f2bf(lo) | (f2bf(hi) << 16); }
__device__ __forceinline__ float bflo(unsigned w) { return __builtin_bit_cast(float, w << 16); }
__device__ __forceinline__ float bfhi(unsigned w) { return __builtin_bit_cast(float, w & 0xffff0000u); }
__device__ __forceinline__ float wave_sum(float v) {
#pragma unroll
    for (int o = 1; o < 64; o <<= 1) v += __shfl_xor(v, o);
    return v;
}
__device__ __forceinline__ float silu(float x) { return x / (1.f + __expf(-x)); }

__device__ __forceinline__ int lane_id() { int l; asm volatile("v_mbcnt_lo_u32_b32 %0, -1, 0\n\tv_mbcnt_hi_u32_b32 %0, -1, %0" : "=v"(l)); return l; }
#define XB_TMO      128
#define XB_XCNT(j)  (256  + 64 * (j))
#define XB_XSUB(j)  (1280 + 64 * (j))
#define XB_XGEN(j)  (2304 + 64 * (j))
#define XB_TOP      3328
#define XB_TOPGEN   3392
#define XCD_BAR_WORDS 3456
#define XB_SPIN_CAP (1u << 18)

__device__ __forceinline__ unsigned xb_ld(unsigned* p)              { return __hip_atomic_load(p, __ATOMIC_RELAXED, __HIP_MEMORY_SCOPE_AGENT); }
__device__ __forceinline__ unsigned xb_add(unsigned* p, unsigned v) { return __hip_atomic_fetch_add(p, v, __ATOMIC_RELAXED, __HIP_MEMORY_SCOPE_AGENT); }
__device__ __forceinline__ unsigned xb_xcc_id() { return (unsigned)__builtin_amdgcn_s_getreg((3 << 11) | 20) & 0xFu; }
#define XB_SPIN(cond, bar) do { unsigned _sp = 0; while (cond) { __builtin_amdgcn_s_sleep(1); \
    if ((++_sp & 255u) == 0u) { if (xb_ld(&(bar)[XB_TMO])) break; if (_sp > XB_SPIN_CAP) { atomicAdd(&(bar)[XB_TMO], 1u); break; } } } } while (0)

struct XcdBarrier {
    unsigned* bar; unsigned x; int w;
    volatile LAS unsigned* st;
};

__device__ __forceinline__ XcdBarrier xcd_barrier_post(unsigned* bar, volatile LAS unsigned* st, int wave_) {
    XcdBarrier b; b.bar = bar; b.x = xb_xcc_id(); b.st = st; b.w = wave_;
    if (wave_ == 0 && lane_id() == 0) (void)xb_add(&bar[XB_XCNT(b.x)], 1u);
    return b;
}
__device__ __forceinline__ void xcd_barrier_complete(unsigned* bar, unsigned x, unsigned& nloc, unsigned& nx) {
    const unsigned G = gridDim.x * gridDim.y * gridDim.z;
    unsigned sum, cnt, mine, sp = 0u;
    for (;;) {
        sum = 0u; cnt = 0u; mine = 0u;
#pragma unroll
        for (unsigned j = 0; j < 16; ++j) { const unsigned c = xb_ld(&bar[XB_XCNT(j)]); sum += c; cnt += (c > 0u) ? 1u : 0u; mine = (j == x) ? c : mine; }
        if (sum == G) break;
        __builtin_amdgcn_s_sleep(1);
        if ((++sp & 255u) == 0u) { if (xb_ld(&bar[XB_TMO])) break; if (sp > XB_SPIN_CAP) { atomicAdd(&bar[XB_TMO], 1u); break; } }
    }
    nloc = mine > 0u ? mine : 1u; nx = cnt > 0u ? cnt : 1u;
}

__device__ __forceinline__ void xcd_barrier(const XcdBarrier& b) {
    asm volatile("s_waitcnt vmcnt(0)" ::: "memory");
    __syncthreads();
    if (b.w == 0 && lane_id() == 0) {
        unsigned* bar = b.bar;
        __builtin_amdgcn_s_waitcnt(0);
        unsigned nloc = b.st[0], nx = b.st[1];
        if (nloc == 0u) { xcd_barrier_complete(bar, b.x, nloc, nx); b.st[0] = nloc; b.st[1] = nx; }
        const unsigned old = xb_add(&bar[XB_XSUB(b.x)], 1u);
        const unsigned gen = old / nloc;
        if (old + 1u == (gen + 1u) * nloc) {
            __builtin_amdgcn_fence(__ATOMIC_RELEASE, "agent");
            asm volatile("s_waitcnt vmcnt(0)" ::: "memory");
            const unsigned og = xb_add(&bar[XB_TOP], 1u);
            const unsigned tg = og / nx;
            if (og + 1u == (tg + 1u) * nx) xb_add(&bar[XB_TOPGEN], 1u);
            else XB_SPIN(xb_ld(&bar[XB_TOPGEN]) == tg, bar);
            __builtin_amdgcn_fence(__ATOMIC_ACQUIRE, "agent");
            xb_add(&bar[XB_XGEN(b.x)], 1u);
            asm volatile("s_waitcnt vmcnt(0)" ::: "memory");
        } else {
            XB_SPIN(xb_ld(&bar[XB_XGEN(b.x)]) == gen, bar);
            __builtin_amdgcn_fence(__ATOMIC_ACQUIRE, "agent");
            asm volatile("s_waitcnt vmcnt(0)" ::: "memory");
        }
    }
    __syncthreads();
}

struct MapIn { __device__ __forceinline__ int operator()(int n) const {
    if (n < 10240) return n; if (n < 12288) return n + 64; if (n < 12352) { const int j = n - 12288; return 10240 + (j & 1) * 32 + (j >> 1); } return -1; } };
struct MapUq { __device__ __forceinline__ int operator()(int n) const {
    if (n < 2048) return (n >> 7) * 192 + (n & 127); const int j = n - 2048, h = j >> 6, jj = j & 63; return h * 192 + 128 + (jj & 1) * 32 + (jj >> 1); } };
struct MapId { __device__ __forceinline__ int operator()(int n) const { return n; } };
struct MapInB { __device__ __forceinline__ int operator()(int n) const { return MapIn{}(n + 12288); } };
struct MapUqB { __device__ __forceinline__ int operator()(int n) const { return MapUq{}(n + 2048); } };
template <bool GATHER, class Map>
__device__ __forceinline__ void p0_transpose_item(const float* W, int K, int Nsrc, int Nd, bf16* WT, LAS float* scr, int item, int lane, Map map) {
    const int nblk = Nd / 64, kb = item / nblk, nb = item % nblk, k0 = 64 * kb, n0 = 64 * nb;
    const int nq = 4 * (lane & 15), kr = lane >> 4;
    f32x4 v[16];
    if constexpr (GATHER) {
        const int s0 = map(n0 + nq), s1 = map(n0 + nq + 1), s2 = map(n0 + nq + 2), s3 = map(n0 + nq + 3);
#pragma unroll
        for (int i = 0; i < 16; ++i) { const float* r = W + (size_t)(k0 + 4 * i + kr) * Nsrc; v[i] = (f32x4){s0 >= 0 ? r[s0] : 0.f, s1 >= 0 ? r[s1] : 0.f, s2 >= 0 ? r[s2] : 0.f, s3 >= 0 ? r[s3] : 0.f}; }
    } else {
        const int s0 = map(n0 + nq);
#pragma unroll
        for (int i = 0; i < 16; ++i) v[i] = s0 >= 0 ? __builtin_nontemporal_load((const f32x4*)(W + (size_t)(k0 + 4 * i + kr) * Nsrc + s0)) : (f32x4){0.f, 0.f, 0.f, 0.f};
    }
#pragma unroll
    for (int i = 0; i < 16; ++i) { LAS float* d = scr + (4 * i + kr) * 65 + nq; d[0] = v[i][0]; d[1] = v[i][1]; d[2] = v[i][2]; d[3] = v[i][3]; }
    LDS_WAIT(); asm volatile("" ::: "memory");
    const int c = lane & 7;
#pragma unroll
    for (int j = 0; j < 8; ++j) { const int n = (lane >> 3) + 8 * j; const LAS float* s = scr + (8 * c) * 65 + n;
        v4u o; o.x = pk2(s[0 * 65], s[1 * 65]); o.y = pk2(s[2 * 65], s[3 * 65]); o.z = pk2(s[4 * 65], s[5 * 65]); o.w = pk2(s[6 * 65], s[7 * 65]);
        *(v4u*)(WT + (size_t)(n0 + n) * K + k0 + 8 * c) = o; }
    LDS_WAIT(); asm volatile("" ::: "memory");
}
__device__ __forceinline__ void rms_row_to_bf16(const float* xrow, const float* g, bf16* orow, int lane) {
    const f32x4* xr = (const f32x4*)xrow + lane; const f32x4* gr = (const f32x4*)g + lane;
    f32x4 v[16]; float s = 0.f;
#pragma unroll
    for (int j = 0; j < 16; ++j) { v[j] = __builtin_nontemporal_load(xr + 64 * j); s += (v[j].x * v[j].x + v[j].y * v[j].y) + (v[j].z * v[j].z + v[j].w * v[j].w); }
    const float rstd = 1.f / sqrtf(wave_sum(s) * (1.f / D_MODEL) + RMS_EPS);
    unsigned long long* o8 = (unsigned long long*)orow + lane;
#pragma unroll
    for (int j = 0; j < 16; ++j) { const f32x4 gg = gr[64 * j];
        o8[64 * j] = (unsigned long long)pk2(v[j].x * rstd * gg.x, v[j].y * rstd * gg.y) | ((unsigned long long)pk2(v[j].z * rstd * gg.z, v[j].w * rstd * gg.w) << 32); }
}

typedef short bf16x8 __attribute__((ext_vector_type(8)));
template <int RB, int NB>
__device__ __forceinline__ void mini_gemm(const bf16* A, size_t lda, const bf16* Bt, size_t ldb, int K, f32x4 (&acc)[RB][NB], int lane) {
    const bf16* ap = A + (size_t)(lane & 15) * lda + 8 * (lane >> 4); const bf16* bp = Bt + (size_t)(lane & 15) * ldb + 8 * (lane >> 4);
#pragma unroll
    for (int rb = 0; rb < RB; ++rb)
#pragma unroll
        for (int nb = 0; nb < NB; ++nb) acc[rb][nb] = (f32x4){0.f, 0.f, 0.f, 0.f};
#pragma unroll 4
    for (int k0 = 0; k0 < K; k0 += 32) { bf16x8 a[RB], b[NB];
#pragma unroll
        for (int rb = 0; rb < RB; ++rb) a[rb] = *(const bf16x8*)(ap + (size_t)rb * 16 * lda + k0);
#pragma unroll
        for (int nb = 0; nb < NB; ++nb) b[nb] = *(const bf16x8*)(bp + (size_t)nb * 16 * ldb + k0);
#pragma unroll
        for (int rb = 0; rb < RB; ++rb)
#pragma unroll
            for (int nb = 0; nb < NB; ++nb) acc[rb][nb] = __builtin_amdgcn_mfma_f32_16x16x32_bf16(a[rb], b[nb], acc[rb][nb], 0, 0, 0); }
}
template <int RB, int NB>
__device__ __forceinline__ void wg_task(const bf16* A, const bf16* Bt, LAS float* red, f32x4 (&res)[RB * NB / 4], int wave, int lane) {
    f32x4 acc[RB][NB]; mini_gemm<RB, NB>(A + 512 * wave, 4096, Bt + 512 * wave, 4096, 512, acc, lane);
#pragma unroll
    for (int r = 0; r < RB * NB / 4; ++r) {
#pragma unroll
        for (int i = 0; i < 4; ++i) *(LAS f32x4*)(red + ((wave * 4 + i) * 64 + lane) * 4) = acc[(4 * r + i) / NB][(4 * r + i) % NB];
        __syncthreads();
        f32x4 s = {0.f, 0.f, 0.f, 0.f};
        if (wave < 4) {
#pragma unroll
            for (int w = 0; w < 8; ++w) s += *(LAS f32x4*)(red + ((w * 4 + wave) * 64 + lane) * 4); }
        res[r] = s;
        __syncthreads(); }
}

__device__ const unsigned short ATT_ORDER[3072] = {
    32783,32799,32815,32831,32847,32863,32879,32895,32911,32927,32943,32959,32975,32991,33007,33023,33039,33055,33071,33087,33103,33119,33135,33151,33167,33183,33199,33215,33231,33247,33263,33279,
    33295,33311,33327,33343,33359,33375,33391,33407,33423,33439,33455,33471,33487,33503,33519,33535,33551,33567,33583,33599,33615,33631,33647,33663,33679,33695,33711,33727,33743,33759,33775,33791,
    32782,32798,32814,32830,32846,32862,32878,32894,32910,32926,32942,32958,32974,32990,33006,33022,33038,33054,33070,33086,33102,33118,33134,33150,33166,33182,33198,33214,33230,33246,33262,33278,
    33294,33310,33326,33342,33358,33374,33390,33406,33422,33438,33454,33470,33486,33502,33518,33534,33550,33566,33582,33598,33614,33630,33646,33662,33678,33694,33710,33726,33742,33758,33774,33790,
    32781,32797,32813,32829,32845,32861,32877,32893,32909,32925,32941,32957,32973,32989,33005,33021,33037,33053,33069,33085,33101,33117,33133,33149,33165,33181,33197,33213,33229,33245,33261,33277,
    33293,33309,33325,33341,33357,33373,33389,33405,33421,33437,33453,33469,33485,33501,33517,33533,33549,33565,33581,33597,33613,33629,33645,33661,33677,33693,33709,33725,33741,33757,33773,33789,
    32780,32796,32812,32828,32844,32860,32876,32892,32908,32924,32940,32956,32972,32988,33004,33020,33036,33052,33068,33084,33100,33116,33132,33148,33164,33180,33196,33212,33228,33244,33260,33276,
    33292,33308,33324,33340,33356,33372,33388,33404,33420,33436,33452,33468,33484,33500,33516,33532,33548,33564,33580,33596,33612,33628,33644,33660,33676,33692,33708,33724,33740,33756,33772,33788,
    32779,32795,32811,32827,32843,32859,32875,32891,32907,32923,32939,32955,32971,32987,33003,33019,33035,33051,33067,33083,33099,33115,33131,33147,33163,33179,33195,33211,33227,33243,33259,33275,
    33291,33307,33323,33339,33355,33371,33387,33403,33419,33435,33451,33467,33483,33499,33515,33531,33547,33563,33579,33595,33611,33627,33643,33659,33675,33691,33707,33723,33739,33755,33771,33787,
    32778,32794,32810,32826,32842,32858,32874,32890,32906,32922,32938,32954,32970,32986,33002,33018,33034,33050,33066,33082,33098,33114,33130,33146,33162,33178,33194,33210,33226,33242,33258,33274,
    33290,33306,33322,33338,33354,33370,33386,33402,33418,33434,33450,33466,33482,33498,33514,33530,33546,33562,33578,33594,33610,33626,33642,33658,33674,33690,33706,33722,33738,33754,33770,33786,
    32777,32793,32809,32825,32841,32857,32873,32889,32905,32921,32937,32953,32969,32985,33001,33017,33033,33049,33065,33081,33097,33113,33129,33145,33161,33177,33193,33209,33225,33241,33257,33273,
    33289,33305,33321,33337,33353,33369,33385,33401,33417,33433,33449,33465,33481,33497,33513,33529,33545,33561,33577,33593,33609,33625,33641,33657,33673,33689,33705,33721,33737,33753,33769,33785,
    287,319,351,383,415,447,479,511,799,831,863,895,927,959,991,1023,1311,1343,1375,1407,1439,1471,1503,1535,1823,1855,1887,1919,1951,1983,2015,2047,
    286,318,350,382,414,446,478,510,798,830,862,894,926,958,990,1022,1310,1342,1374,1406,1438,1470,1502,1534,1822,1854,1886,1918,1950,1982,2014,2046,
    285,317,349,381,413,445,477,509,797,829,861,893,925,957,989,1021,1309,1341,1373,1405,1437,1469,1501,1533,1821,1853,1885,1917,1949,1981,2013,2045,
    32776,32792,32808,32824,32840,32856,32872,32888,32904,32920,32936,32952,32968,32984,33000,33016,33032,33048,33064,33080,33096,33112,33128,33144,33160,33176,33192,33208,33224,33240,33256,33272,
    33288,33304,33320,33336,33352,33368,33384,33400,33416,33432,33448,33464,33480,33496,33512,33528,33544,33560,33576,33592,33608,33624,33640,33656,33672,33688,33704,33720,33736,33752,33768,33784,
    284,316,348,380,412,444,476,508,796,828,860,892,924,956,988,1020,1308,1340,1372,1404,1436,1468,1500,1532,1820,1852,1884,1916,1948,1980,2012,2044,
    283,315,347,379,411,443,475,507,795,827,859,891,923,955,987,1019,1307,1339,1371,1403,1435,1467,1499,1531,1819,1851,1883,1915,1947,1979,2011,2043,
    282,314,346,378,410,442,474,506,794,826,858,890,922,954,986,1018,1306,1338,1370,1402,1434,1466,1498,1530,1818,1850,1882,1914,1946,1978,2010,2042,
    32775,32791,32807,32823,32839,32855,32871,32887,32903,32919,32935,32951,32967,32983,32999,33015,33031,33047,33063,33079,33095,33111,33127,33143,33159,33175,33191,33207,33223,33239,33255,33271,
    33287,33303,33319,33335,33351,33367,33383,33399,33415,33431,33447,33463,33479,33495,33511,33527,33543,33559,33575,33591,33607,33623,33639,33655,33671,33687,33703,33719,33735,33751,33767,33783,
    281,313,345,377,409,441,473,505,793,825,857,889,921,953,985,1017,1305,1337,1369,1401,1433,1465,1497,1529,1817,1849,1881,1913,1945,1977,2009,2041,
    280,312,344,376,408,440,472,504,792,824,856,888,920,952,984,1016,1304,1336,1368,1400,1432,1464,1496,1528,1816,1848,1880,1912,1944,1976,2008,2040,
    279,311,343,375,407,439,471,503,791,823,855,887,919,951,983,1015,1303,1335,1367,1399,1431,1463,1495,1527,1815,1847,1879,1911,1943,1975,2007,2039,
    278,310,342,374,406,438,470,502,790,822,854,886,918,950,982,1014,1302,1334,1366,1398,1430,1462,1494,1526,1814,1846,1878,1910,1942,1974,2006,2038,
    32774,32790,32806,32822,32838,32854,32870,32886,32902,32918,32934,32950,32966,32982,32998,33014,33030,33046,33062,33078,33094,33110,33126,33142,33158,33174,33190,33206,33222,33238,33254,33270,
    33286,33302,33318,33334,33350,33366,33382,33398,33414,33430,33446,33462,33478,33494,33510,33526,33542,33558,33574,33590,33606,33622,33638,33654,33670,33686,33702,33718,33734,33750,33766,33782,
    277,309,341,373,405,437,469,501,789,821,853,885,917,949,981,1013,1301,1333,1365,1397,1429,1461,1493,1525,1813,1845,1877,1909,1941,1973,2005,2037,
    276,308,340,372,404,436,468,500,788,820,852,884,916,948,980,1012,1300,1332,1364,1396,1428,1460,1492,1524,1812,1844,1876,1908,1940,1972,2004,2036,
    275,307,339,371,403,435,467,499,787,819,851,883,915,947,979,1011,1299,1331,1363,1395,1427,1459,1491,1523,1811,1843,1875,1907,1939,1971,2003,2035,
    32773,32789,32805,32821,32837,32853,32869,32885,32901,32917,32933,32949,32965,32981,32997,33013,33029,33045,33061,33077,33093,33109,33125,33141,33157,33173,33189,33205,33221,33237,33253,33269,
    33285,33301,33317,33333,33349,33365,33381,33397,33413,33429,33445,33461,33477,33493,33509,33525,33541,33557,33573,33589,33605,33621,33637,33653,33669,33685,33701,33717,33733,33749,33765,33781,
    274,306,338,370,402,434,466,498,786,818,850,882,914,946,978,1010,1298,1330,1362,1394,1426,1458,1490,1522,1810,1842,1874,1906,1938,1970,2002,2034,
    273,305,337,369,401,433,465,497,785,817,849,881,913,945,977,1009,1297,1329,1361,1393,1425,1457,1489,1521,1809,1841,1873,1905,1937,1969,2001,2033,
    208,209,210,211,212,213,214,215,216,217,218,219,220,221,222,223,240,241,242,243,244,245,246,247,248,249,250,251,252,253,254,255,
    272,304,336,368,400,432,464,496,720,721,722,723,724,725,726,727,728,729,730,731,732,733,734,735,752,753,754,755,756,757,758,759,
    760,761,762,763,764,765,766,767,784,816,848,880,912,944,976,1008,1232,1233,1234,1235,1236,1237,1238,1239,1240,1241,1242,1243,1244,1245,1246,1247,
    1264,1265,1266,1267,1268,1269,1270,1271,1272,1273,1274,1275,1276,1277,1278,1279,1296,1328,1360,1392,1424,1456,1488,1520,1744,1745,1746,1747,1748,1749,1750,1751,
    1752,1753,1754,1755,1756,1757,1758,1759,1776,1777,1778,1779,1780,1781,1782,1783,1784,1785,1786,1787,1788,1789,1790,1791,1808,1840,1872,1904,1936,1968,2000,2032,
    32772,32788,32804,32820,32836,32852,32868,32884,32900,32916,32932,32948,32964,32980,32996,33012,33028,33044,33060,33076,33092,33108,33124,33140,33156,33172,33188,33204,33220,33236,33252,33268,
    33284,33300,33316,33332,33348,33364,33380,33396,33412,33428,33444,33460,33476,33492,33508,33524,33540,33556,33572,33588,33604,33620,33636,33652,33668,33684,33700,33716,33732,33748,33764,33780,
    207,239,271,303,335,367,399,431,463,495,719,751,783,815,847,879,911,943,975,1007,1231,1263,1295,1327,1359,1391,1423,1455,1487,1519,1743,1775,
    1807,1839,1871,1903,1935,1967,1999,2031,206,238,270,302,334,366,398,430,462,494,718,750,782,814,846,878,910,942,974,1006,1230,1262,1294,1326,
    1358,1390,1422,1454,1486,1518,1742,1774,1806,1838,1870,1902,1934,1966,1998,2030,205,237,269,301,333,365,397,429,461,493,717,749,781,813,845,877,
    909,941,973,1005,1229,1261,1293,1325,1357,1389,1421,1453,1485,1517,1741,1773,1805,1837,1869,1901,1933,1965,1997,2029,32771,32787,32803,32819,32835,32851,32867,32883,
    32899,32915,32931,32947,32963,32979,32995,33011,33027,33043,33059,33075,33091,33107,33123,33139,33155,33171,33187,33203,33219,33235,33251,33267,33283,33299,33315,33331,33347,33363,33379,33395,
    33411,33427,33443,33459,33475,33491,33507,33523,33539,33555,33571,33587,33603,33619,33635,33651,33667,33683,33699,33715,33731,33747,33763,33779,204,236,268,300,332,364,396,428,
    460,492,716,748,780,812,844,876,908,940,972,1004,1228,1260,1292,1324,1356,1388,1420,1452,1484,1516,1740,1772,1804,1836,1868,1900,1932,1964,1996,2028,
    203,235,267,299,331,363,395,427,459,491,715,747,779,811,843,875,907,939,971,1003,1227,1259,1291,1323,1355,1387,1419,1451,1483,1515,1739,1771,
    1803,1835,1867,1899,1931,1963,1995,2027,202,234,266,298,330,362,394,426,458,490,714,746,778,810,842,874,906,938,970,1002,1226,1258,1290,1322,
    1354,1386,1418,1450,1482,1514,1738,1770,1802,1834,1866,1898,1930,1962,1994,2026,201,233,265,297,329,361,393,425,457,489,713,745,777,809,841,873,
    905,937,969,1001,1225,1257,1289,1321,1353,1385,1417,1449,1481,1513,1737,1769,1801,1833,1865,1897,1929,1961,1993,2025,32770,32786,32802,32818,32834,32850,32866,32882,
    32898,32914,32930,32946,32962,32978,32994,33010,33026,33042,33058,33074,33090,33106,33122,33138,33154,33170,33186,33202,33218,33234,33250,33266,33282,33298,33314,33330,33346,33362,33378,33394,
    33410,33426,33442,33458,33474,33490,33506,33522,33538,33554,33570,33586,33602,33618,33634,33650,33666,33682,33698,33714,33730,33746,33762,33778,136,137,138,139,140,141,142,143,
    144,145,146,147,148,149,150,151,152,153,154,155,156,157,158,159,168,169,170,171,172,173,174,175,176,177,178,179,180,181,182,183,
    184,185,186,187,188,189,190,191,200,232,264,296,328,360,392,424,456,488,648,649,650,651,652,653,654,655,656,657,658,659,660,661,
    662,663,664,665,666,667,668,669,670,671,680,681,682,683,684,685,686,687,688,689,690,691,692,693,694,695,696,697,698,699,700,701,
    702,703,712,744,776,808,840,872,904,936,968,1000,1160,1161,1162,1163,1164,1165,1166,1167,1168,1169,1170,1171,1172,1173,1174,1175,1176,1177,1178,1179,
    1180,1181,1182,1183,1192,1193,1194,1195,1196,1197,1198,1199,1200,1201,1202,1203,1204,1205,1206,1207,1208,1209,1210,1211,1212,1213,1214,1215,1224,1256,1288,1320,
    1352,1384,1416,1448,1480,1512,1672,1673,1674,1675,1676,1677,1678,1679,1680,1681,1682,1683,1684,1685,1686,1687,1688,1689,1690,1691,1692,1693,1694,1695,1704,1705,
    1706,1707,1708,1709,1710,1711,1712,1713,1714,1715,1716,1717,1718,1719,1720,1721,1722,1723,1724,1725,1726,1727,1736,1768,1800,1832,1864,1896,1928,1960,1992,2024,
    135,167,199,231,263,295,327,359,391,423,455,487,647,679,711,743,775,807,839,871,903,935,967,999,1159,1191,1223,1255,1287,1319,1351,1383,
    1415,1447,1479,1511,1671,1703,1735,1767,1799,1831,1863,1895,1927,1959,1991,2023,134,166,198,230,262,294,326,358,390,422,454,486,646,678,710,742,
    774,806,838,870,902,934,966,998,1158,1190,1222,1254,1286,1318,1350,1382,1414,1446,1478,1510,1670,1702,1734,1766,1798,1830,1862,1894,1926,1958,1990,2022,
    32769,32785,32801,32817,32833,32849,32865,32881,32897,32913,32929,32945,32961,32977,32993,33009,33025,33041,33057,33073,33089,33105,33121,33137,33153,33169,33185,33201,33217,33233,33249,33265,
    33281,33297,33313,33329,33345,33361,33377,33393,33409,33425,33441,33457,33473,33489,33505,33521,33537,33553,33569,33585,33601,33617,33633,33649,33665,33681,33697,33713,33729,33745,33761,33777,
    133,165,197,229,261,293,325,357,389,421,453,485,645,677,709,741,773,805,837,869,901,933,965,997,1157,1189,1221,1253,1285,1317,1349,1381,
    1413,1445,1477,1509,1669,1701,1733,1765,1797,1829,1861,1893,1925,1957,1989,2021,68,69,70,71,72,73,74,75,76,77,78,79,80,81,82,83,
    84,85,86,87,88,89,90,91,92,93,94,95,100,101,102,103,104,105,106,107,108,109,110,111,112,113,114,115,116,117,118,119,
    120,121,122,123,124,125,126,127,132,164,196,228,260,292,324,356,388,420,452,484,580,581,582,583,584,585,586,587,588,589,590,591,
    592,593,594,595,596,597,598,599,600,601,602,603,604,605,606,607,612,613,614,615,616,617,618,619,620,621,622,623,624,625,626,627,
    628,629,630,631,632,633,634,635,636,637,638,639,644,676,708,740,772,804,836,868,900,932,964,996,1092,1093,1094,1095,1096,1097,1098,1099,
    1100,1101,1102,1103,1104,1105,1106,1107,1108,1109,1110,1111,1112,1113,1114,1115,1116,1117,1118,1119,1124,1125,1126,1127,1128,1129,1130,1131,1132,1133,1134,1135,
    1136,1137,1138,1139,1140,1141,1142,1143,1144,1145,1146,1147,1148,1149,1150,1151,1156,1188,1220,1252,1284,1316,1348,1380,1412,1444,1476,1508,1604,1605,1606,1607,
    1608,1609,1610,1611,1612,1613,1614,1615,1616,1617,1618,1619,1620,1621,1622,1623,1624,1625,1626,1627,1628,1629,1630,1631,1636,1637,1638,1639,1640,1641,1642,1643,
    1644,1645,1646,1647,1648,1649,1650,1651,1652,1653,1654,1655,1656,1657,1658,1659,1660,1661,1662,1663,1668,1700,1732,1764,1796,1828,1860,1892,1924,1956,1988,2020,
    67,99,131,163,195,227,259,291,323,355,387,419,451,483,579,611,643,675,707,739,771,803,835,867,899,931,963,995,1091,1123,1155,1187,
    1219,1251,1283,1315,1347,1379,1411,1443,1475,1507,1603,1635,1667,1699,1731,1763,1795,1827,1859,1891,1923,1955,1987,2019,32768,32784,32800,32816,32832,32848,32864,32880,
    32896,32912,32928,32944,32960,32976,32992,33008,33024,33040,33056,33072,33088,33104,33120,33136,33152,33168,33184,33200,33216,33232,33248,33264,33280,33296,33312,33328,33344,33360,33376,33392,
    33408,33424,33440,33456,33472,33488,33504,33520,33536,33552,33568,33584,33600,33616,33632,33648,33664,33680,33696,33712,33728,33744,33760,33776,2,3,4,5,6,7,8,9,
    10,11,12,13,14,15,16,17,18,19,20,21,22,23,24,25,26,27,28,29,30,31,34,35,36,37,38,39,40,41,42,43,
    44,45,46,47,48,49,50,51,52,53,54,55,56,57,58,59,60,61,62,63,66,98,130,162,194,226,258,290,322,354,386,418,
    450,482,514,515,516,517,518,519,520,521,522,523,524,525,526,527,528,529,530,531,532,533,534,535,536,537,538,539,540,541,542,543,
    546,547,548,549,550,551,552,553,554,555,556,557,558,559,560,561,562,563,564,565,566,567,568,569,570,571,572,573,574,575,578,610,
    642,674,706,738,770,802,834,866,898,930,962,994,1026,1027,1028,1029,1030,1031,1032,1033,1034,1035,1036,1037,1038,1039,1040,1041,1042,1043,1044,1045,
    1046,1047,1048,1049,1050,1051,1052,1053,1054,1055,1058,1059,1060,1061,1062,1063,1064,1065,1066,1067,1068,1069,1070,1071,1072,1073,1074,1075,1076,1077,1078,1079,
    1080,1081,1082,1083,1084,1085,1086,1087,1090,1122,1154,1186,1218,1250,1282,1314,1346,1378,1410,1442,1474,1506,1538,1539,1540,1541,1542,1543,1544,1545,1546,1547,
    1548,1549,1550,1551,1552,1553,1554,1555,1556,1557,1558,1559,1560,1561,1562,1563,1564,1565,1566,1567,1570,1571,1572,1573,1574,1575,1576,1577,1578,1579,1580,1581,
    1582,1583,1584,1585,1586,1587,1588,1589,1590,1591,1592,1593,1594,1595,1596,1597,1598,1599,1602,1634,1666,1698,1730,1762,1794,1826,1858,1890,1922,1954,1986,2018,
    1,33,65,97,129,161,193,225,257,289,321,353,385,417,449,481,513,545,577,609,641,673,705,737,769,801,833,865,897,929,961,993,
    1025,1057,1089,1121,1153,1185,1217,1249,1281,1313,1345,1377,1409,1441,1473,1505,1537,1569,1601,1633,1665,1697,1729,1761,1793,1825,1857,1889,1921,1953,1985,2017,
    0,32,64,96,128,160,192,224,256,288,320,352,384,416,448,480,512,544,576,608,640,672,704,736,768,800,832,864,896,928,960,992,
    1024,1056,1088,1120,1152,1184,1216,1248,1280,1312,1344,1376,1408,1440,1472,1504,1536,1568,1600,1632,1664,1696,1728,1760,1792,1824,1856,1888,1920,1952,1984,2016,
};

struct Args { const float* in[15]; float* out; unsigned char* ws; int ph_lo, ph_hi; };
__global__ void __launch_bounds__(NWAVES * 64, 2) hybrid_fwd(Args args) {
    extern __shared__ __attribute__((aligned(16))) unsigned char lds[];
    cg::grid_group grid = cg::this_grid();
    const int wave = __builtin_amdgcn_readfirstlane((int)threadIdx.x >> 6);
#define lane lane_id()
#define tid (wave * 64 + lane_id())
    const int G = gridDim.x, bx = blockIdx.x, vcu = (G % 8 == 0) ? (bx % 8) * (G / 8) + bx / 8 : bx;
    const int gw = vcu * NWAVES + wave, NGW = G * NWAVES;
    unsigned char* ws = args.ws;
    const float* x = args.in[0]; const float* meta = args.in[1]; const float* g_pre = args.in[2]; const float* w_in = args.in[3];
    const float* lq1 = args.in[4]; const float* lk1 = args.in[5]; const float* lq2 = args.in[6]; const float* lk2 = args.in[7];
    const float* subln = args.in[8]; const float* g_cq = args.in[9]; const float* g_ckv = args.in[10];
    const float* w_uq = args.in[11]; const float* w_ukv = args.in[12]; const float* w_out = args.in[13]; const float* g_post = args.in[14];
    float* out = args.out;
    bf16* Wt_in = (bf16*)(ws + WS_WIN); bf16* Wt_uq = (bf16*)(ws + WS_WUQ); bf16* Wt_ukv = (bf16*)(ws + WS_WUKV); bf16* Wt_out = (bf16*)(ws + WS_WOUT);
    float* cosT = (float*)(ws + WS_TAB); float* sinT = cosT + 4112 * 32;
    float* KN2 = (float*)(ws + WS_TAB + 1536 * 1024); float* QST = KN2 + 16 * 4 * 65; float* CKVM = QST + 16 * 4 * 128;
    bf16* XN = (bf16*)(ws + WS_XN); bf16* MIX = XN;
    bf16* QD = (bf16*)(ws + WS_QD); bf16* KD = (bf16*)(ws + WS_KD); bf16* VD = (bf16*)(ws + WS_VD); bf16* GD = (bf16*)(ws + WS_GD);
    bf16* CQ = (bf16*)(ws + WS_CQ); bf16* CKV = (bf16*)(ws + WS_CKV); bf16* GM = (bf16*)(ws + WS_GM); bf16* KR = (bf16*)(ws + WS_KR);
    bf16* QN = (bf16*)(ws + WS_QN); bf16* QR = (bf16*)(ws + WS_QR); bf16* KV = (bf16*)(ws + WS_KV);
    bf16* Y16 = (bf16*)(ws + WS_QD);     bf16* O1 = (bf16*)(ws + WS_O1); bf16* O2 = (bf16*)(ws + WS_O2); bf16* OB = (bf16*)(ws + WS_OB);
    const int lo = args.ph_lo, hi_ph = args.ph_hi;
    for (int w_ = tid; w_ < (LDS_BYTES - LDSCTL_OFF) / 4; w_ += NWAVES * 64) ((LAS unsigned*)((LAS unsigned char*)lds + LDSCTL_OFF))[w_] = 0u;
    __syncthreads();
    XcdBarrier bar = xcd_barrier_post((unsigned*)(ws + WS_CTL), (volatile LAS unsigned*)((LAS unsigned char*)lds + MISC_OFF) + 8, wave);
    if (lo == 0x7fffffff) grid.sync();
#ifndef PH_MASK
#define PH_MASK 0xff
#endif
#define IN(k) (((PH_MASK >> (k)) & 1) && lo <= (k) && (k) < hi_ph)
#ifndef REP_MASK
#define REP_MASK 0
#endif
#define REP(k) (((REP_MASK >> (k)) & 1) ? 2 : 1)
#define SEAM(k) do { if (lo <= (k) && (k) + 1 < hi_ph) xcd_barrier(bar); } while (0)

    if (IN(0)) for (int rep_ = 0; rep_ < REP(0); ++rep_) {
        LAS float* scr = (LAS float*)((LAS unsigned char*)lds + wave * 16640);
        constexpr int I_INA = (4096 / 64) * (12288 / 64), I_INB = (4096 / 64) * (256 / 64), I_UQA = (Q_LORA / 64) * (2048 / 64), I_UQB = (Q_LORA / 64) * (1024 / 64), I_UKV = (KV_LORA / 64) * (4096 / 64), I_OUT = (4096 / 64) * (4096 / 64);
        constexpr int NITEMS = I_INA + I_INB + I_UQA + I_UQB + I_UKV + I_OUT;
        for (int it = gw; it < NITEMS; it += NGW) {
            int r = it;
            if (r < I_INA) { p0_transpose_item<false>(w_in, 4096, 12352, 12288, Wt_in, scr, r, lane, MapIn{}); continue; } r -= I_INA;
            if (r < I_INB) { p0_transpose_item<true>(w_in, 4096, 12352, 256, Wt_in + (size_t)12288 * 4096, scr, r, lane, MapInB{}); continue; } r -= I_INB;
            if (r < I_UQA) { p0_transpose_item<false>(w_uq, Q_LORA, 3072, 2048, Wt_uq, scr, r, lane, MapUq{}); continue; } r -= I_UQA;
            if (r < I_UQB) { p0_transpose_item<true>(w_uq, Q_LORA, 3072, 1024, Wt_uq + (size_t)2048 * Q_LORA, scr, r, lane, MapUqB{}); continue; } r -= I_UQB;
            if (r < I_UKV) { p0_transpose_item<false>(w_ukv, KV_LORA, 4096, 4096, Wt_ukv, scr, r, lane, MapId{}); continue; } r -= I_UKV;
            p0_transpose_item<false>(w_out, 4096, 4096, 4096, Wt_out, scr, r, lane, MapId{});
        }
        for (int m = gw; m < MP; m += NGW) {
            if (m < MR) rms_row_to_bf16(x + (size_t)m * D_MODEL, g_pre, XN + (size_t)m * D_MODEL, lane);
            else { const int mm = (m - MR) & 63;
                if (mm < N_META) rms_row_to_bf16(meta + (size_t)mm * D_MODEL, g_pre, XN + (size_t)m * D_MODEL, lane);
                else { v4u z = {0u, 0u, 0u, 0u}; v4u* o = (v4u*)(XN + (size_t)m * D_MODEL) + lane;
#pragma unroll
                    for (int j = 0; j < 8; ++j) o[64 * j] = z; } }
        }
        for (int blk = gw; blk < 256; blk += NGW) { const int tns = blk >> 6, hb = blk & 63;
            bf16* base = (tns == 0 ? KD : tns == 1 ? VD : KV + (size_t)(tns - 2) * 16 * MP * 128) + ((size_t)(hb >> 2) * MP + MR + 64 * (hb & 3) + 16) * 128;
            const v4u z = {0u, 0u, 0u, 0u};
#pragma unroll
            for (int j = 0; j < 12; ++j) ((v4u*)base)[64 * j + lane] = z; }
        for (int e = gw * 64 + lane; e < 4112 * 32; e += NGW * 64) { const int pos = e >> 5, i = e & 31;
            const float inv_freq = exp2f(-(float)(2 * i) * (13.287712379549449f / 64.f));
            const double rev = (double)pos * (double)inv_freq * 0.15915494309189535; const float fr = (float)(rev - floor(rev));
            cosT[e] = __builtin_amdgcn_cosf(fr); sinT[e] = __builtin_amdgcn_sinf(fr); }
    }
    SEAM(0);
    if (IN(1)) for (int rep_ = 0; rep_ < (REP(1) == 2 ? hi_ph - 6 : 1); ++rep_) {
        pg8::Gemm g{XN, Wt_in, MR, 12288, 4096}; pg8::StaticOrder S; S.init(MR, 12288, G, bx);
        pg8::EpiZ E{QD, KD, VD, GD, CQ, CKV, GM, KR, cosT, sinT, 0.08838834764831845f};
        pg8::gemm_phase<pg8::EpiZ, pg8::StaticOrder, false, true>((LAS unsigned char*)lds, g, S, E, wave);
    }
    SEAM(1);
    if (IN(2)) {
        f32x4 gq[6], gk[2];
#pragma unroll
        for (int j = 0; j < 3; ++j) { gq[2 * j] = *(const f32x4*)(g_cq + 512 * j + 8 * lane); gq[2 * j + 1] = *(const f32x4*)(g_cq + 512 * j + 8 * lane + 4); }
        gk[0] = *(const f32x4*)(g_ckv + 8 * lane); gk[1] = *(const f32x4*)(g_ckv + 8 * lane + 4);
        for (int rep_ = 0; rep_ < (REP(9) == 2 ? hi_ph - 6 : 1); ++rep_) if (G == 256) { LAS float* red = (LAS float*)lds; const int c = lane & 15, q = lane >> 4;
            if (vcu < 208) { const int r0 = 80 * vcu; f32x4 res[5];
                wg_task<5, 4>(XN + (size_t)r0 * 4096, Wt_in + (size_t)12288 * 4096, red, res, wave, lane);
                if (wave < 4) {
#pragma unroll
                    for (int rb = 0; rb < 5; ++rb)
#pragma unroll
                        for (int rg = 0; rg < 4; ++rg) { const int row = r0 + 16 * rb + 4 * q + rg, pos = row < MR ? 16 + (row & 4095) : ((row - MR) & 63), col = 16 * wave + c;
                            const float xs = res[rb][rg], xo = __shfl_xor(xs, 1), cs = cosT[pos * 32 + (col >> 1)], sn = sinT[pos * 32 + (col >> 1)];
                            if ((c & 1) == 0) *(unsigned*)(KR + (size_t)row * 64 + col) = pk2(xs * cs - xo * sn, xs * sn + xo * cs); } }
            } else if (vcu < 240) { const int tsk = vcu - 208, isv = tsk >> 4, n0 = (isv ? 4096 : 2048) + 128 * (tsk & 15); f32x4 res[2];
                wg_task<1, 8>(XN + (size_t)MR * 4096, Wt_in + (size_t)n0 * 4096, red, res, wave, lane);
                bf16* dst = (isv ? VD : KD) + (size_t)(tsk & 15) * MP * 128;
                if (wave < 4) {
#pragma unroll
                    for (int r = 0; r < 2; ++r)
#pragma unroll
                        for (int rg = 0; rg < 4; ++rg) { const int d = 16 * (4 * r + wave) + c; const float xs = res[r][rg], xo = __shfl_xor(xs, 1);
                            if ((c & 1) == 0) { const unsigned w = pk2(xs, xo);
#pragma unroll
                                for (int b = 0; b < 4; ++b) *(unsigned*)(dst + ((size_t)MR + 64 * b + 4 * q + rg) * 128 + d) = w; } } }
            } else if (vcu < 244) { const int tsk = vcu - 240; f32x4 res[2];
                wg_task<1, 8>(XN + (size_t)MR * 4096, Wt_in + (size_t)(9728 + 128 * tsk) * 4096, red, res, wave, lane);
                if (wave < 4) {
#pragma unroll
                    for (int r = 0; r < 2; ++r)
#pragma unroll
                        for (int rg = 0; rg < 4; ++rg) CKVM[(4 * q + rg) * 512 + 128 * tsk + 16 * (4 * r + wave) + c] = res[r][rg]; }
            }
        }
        for (int m = gw; m < MR; m += NGW) {
            { v4u* p = (v4u*)(CQ + (size_t)m * Q_LORA) + lane; v4u v[3]; float s = 0.f;
#pragma unroll
                for (int j = 0; j < 3; ++j) { v[j] = p[64 * j];
#pragma unroll
                    for (int e = 0; e < 4; ++e) { const float a = bflo(v[j][e]), b = bfhi(v[j][e]); s += a * a + b * b; } }
                const float rstd = 1.f / sqrtf(wave_sum(s) * (1.f / Q_LORA) + RMS_EPS);
#pragma unroll
                for (int j = 0; j < 3; ++j) { v4u o;
#pragma unroll
                    for (int e = 0; e < 4; ++e) { const f32x4 gg = gq[2 * j + (e >> 1)];
                        o[e] = pk2(bflo(v[j][e]) * rstd * gg[(e & 1) * 2], bfhi(v[j][e]) * rstd * gg[(e & 1) * 2 + 1]); }
                    p[64 * j] = o; } }
            { v4u* p = (v4u*)(CKV + (size_t)m * KV_LORA) + lane; v4u v = p[0]; float s = 0.f;
#pragma unroll
                for (int e = 0; e < 4; ++e) { const float a = bflo(v[e]), b = bfhi(v[e]); s += a * a + b * b; }
                const float rstd = 1.f / sqrtf(wave_sum(s) * (1.f / KV_LORA) + RMS_EPS); v4u o;
#pragma unroll
                for (int e = 0; e < 4; ++e) { const f32x4 gg = gk[e >> 1]; o[e] = pk2(bflo(v[e]) * rstd * gg[(e & 1) * 2], bfhi(v[e]) * rstd * gg[(e & 1) * 2 + 1]); }
                p[0] = o; }
        }
        for (int rep_ = 0; rep_ < REP(10); ++rep_) for (int id = gw; id < 16 * 4 * 64; id += NGW) { const int hm = id >> 8, b = (id >> 6) & 3, tt = (id & 63) + 1;
            const size_t r0 = (size_t)hm * MP + (tt == 0 ? (size_t)MR + 64 * b : (size_t)b * SEQ + 64 * (tt - 1));
            float kmax = 0.f, qmax = 0.f, smin = 3.0e38f;
#pragma unroll 4
            for (int i = 0; i < 16; ++i) { const size_t off = (r0 + 4 * i + (lane >> 4)) * 128 + 8 * (lane & 15);
                const v4u k8 = *(const v4u*)(KD + off); const v4u q8 = tt ? *(const v4u*)(QD + off) : (v4u){0u, 0u, 0u, 0u};
                float kk = 0.f, qq = 0.f, qk = 0.f;
#pragma unroll
                for (int e = 0; e < 4; ++e) { const float k0 = bflo(k8[e]), k1 = bfhi(k8[e]), q0 = bflo(q8[e]), q1 = bfhi(q8[e]); kk += k0 * k0 + k1 * k1; qq += q0 * q0 + q1 * q1; qk += q0 * k0 + q1 * k1; }
#pragma unroll
                for (int o = 1; o < 16; o <<= 1) { kk += __shfl_xor(kk, o); qq += __shfl_xor(qq, o); qk += __shfl_xor(qk, o); }
                kmax = fmaxf(kmax, kk); qmax = fmaxf(qmax, qq); smin = fminf(smin, qk); }
            kmax = fmaxf(kmax, __shfl_xor(kmax, 16)); kmax = fmaxf(kmax, __shfl_xor(kmax, 32));
            qmax = fmaxf(qmax, __shfl_xor(qmax, 16)); qmax = fmaxf(qmax, __shfl_xor(qmax, 32));
            smin = fminf(smin, __shfl_xor(smin, 16)); smin = fminf(smin, __shfl_xor(smin, 32));
            if (lane == 0) { KN2[(hm * 4 + b) * 65 + tt] = kmax; if (tt) { QST[((hm * 4 + b) * 64 + tt - 1) * 2] = qmax; QST[((hm * 4 + b) * 64 + tt - 1) * 2 + 1] = smin; } }
        }
    }
    SEAM(2);
    if (IN(3)) for (int rep_ = 0; rep_ < REP(3); ++rep_) {
        if (rep_ == 0 && gw < 64) { const int c = lane & 15, q = lane >> 4; f32x4 acc[4];
            const float* xrow = CKVM + c * 512 + 8 * q; float ss = 0.f;
#pragma unroll
            for (int s = 0; s < 16; ++s) { const f32x4 x0 = *(const f32x4*)(xrow + 32 * s), x1 = *(const f32x4*)(xrow + 32 * s + 4);
                ss += (x0[0] * x0[0] + x0[1] * x0[1]) + (x0[2] * x0[2] + x0[3] * x0[3]) + (x1[0] * x1[0] + x1[1] * x1[1]) + (x1[2] * x1[2] + x1[3] * x1[3]); }
            ss += __shfl_xor(ss, 16); ss += __shfl_xor(ss, 32);
            const float rstd = 1.f / sqrtf(ss * (1.f / KV_LORA) + RMS_EPS);
            const bf16* bp = Wt_ukv + (size_t)(64 * gw + c) * KV_LORA + 8 * q;
#pragma unroll
            for (int nb = 0; nb < 4; ++nb) acc[nb] = (f32x4){0.f, 0.f, 0.f, 0.f};
#pragma unroll 4
            for (int s = 0; s < 16; ++s) { const f32x4 x0 = *(const f32x4*)(xrow + 32 * s), x1 = *(const f32x4*)(xrow + 32 * s + 4);
                const f32x4 g0 = *(const f32x4*)(g_ckv + 32 * s + 8 * q), g1 = *(const f32x4*)(g_ckv + 32 * s + 8 * q + 4);
                v4u aw; aw.x = pk2(x0[0] * rstd * g0[0], x0[1] * rstd * g0[1]); aw.y = pk2(x0[2] * rstd * g0[2], x0[3] * rstd * g0[3]);
                aw.z = pk2(x1[0] * rstd * g1[0], x1[1] * rstd * g1[1]); aw.w = pk2(x1[2] * rstd * g1[2], x1[3] * rstd * g1[3]);
                const bf16x8 a = __builtin_bit_cast(bf16x8, aw);
#pragma unroll
                for (int nb = 0; nb < 4; ++nb) { const bf16x8 b = *(const bf16x8*)(bp + (size_t)nb * 16 * KV_LORA + 32 * s); acc[nb] = __builtin_amdgcn_mfma_f32_16x16x32_bf16(a, b, acc[nb], 0, 0, 0); } }
#pragma unroll
            for (int nb = 0; nb < 4; ++nb)
#pragma unroll
                for (int rg = 0; rg < 4; ++rg) { const int nn = 64 * gw + 16 * nb + c, hh = nn >> 7, d = nn & 127;
                    const float xs = acc[nb][rg], xo = __shfl_xor(xs, 1);
                    if ((c & 1) == 0) { const unsigned w = pk2(xs, xo);
#pragma unroll
                        for (int b = 0; b < 4; ++b) *(unsigned*)(KV + ((size_t)hh * MP + MR + 64 * b + 4 * q + rg) * 128 + d) = w; } }
        }
        { pg8::Gemm g{CQ, Wt_uq, MR, 3072, Q_LORA}; pg8::StaticOrder S; S.init(MR, 3072, G, bx);
          pg8::EpiQ E{QN, QR, cosT, sinT, 0.07216878364870323f * LOG2E};
          pg8::gemm_phase<pg8::EpiQ, pg8::StaticOrder, false, true>((LAS unsigned char*)lds, g, S, E, wave); }
        { pg8::Gemm g{CKV, Wt_ukv, MR, 4096, KV_LORA}; pg8::StaticOrder S; S.init(MR, 4096, G, bx);
          pg8::EpiKV E{KV};
          pg8::gemm_phase<pg8::EpiKV, pg8::StaticOrder, false, true>((LAS unsigned char*)lds, g, S, E, wave); }
    }
    SEAM(3);
    if (IN(4)) {
        unsigned* qctr = (unsigned*)(ws + WS_CTL) + 3600;
        volatile LAS unsigned* qslot = (volatile LAS unsigned*)((LAS unsigned char*)lds + MISC_OFF) + 16;
        if (tid == 0) { const unsigned t_ = __hip_atomic_fetch_add(qctr, 1u, __ATOMIC_RELAXED, __HIP_MEMORY_SCOPE_AGENT); qslot[0] = t_ < 3072u ? (unsigned)ATT_ORDER[t_] : 0xffffffffu; }
        for (;;) {
            __syncthreads();
            const unsigned code = (unsigned)__builtin_amdgcn_readfirstlane((int)qslot[0]);
            __syncthreads();
            if (code == 0xffffffffu) break;
            unsigned nxt_ = 0u;
            if (tid == 0) nxt_ = __hip_atomic_fetch_add(qctr, 1u, __ATOMIC_RELAXED, __HIP_MEMORY_SCOPE_AGENT);
            att::Unit u;
            if (!(code & 0x8000u)) { const int qb = code & 31, mp = (code >> 5) & 1, h = (code >> 6) & 7, b = (code >> 9) & 3; att::UnitX ux;
                const size_t qrow = (size_t)b * SEQ + (size_t)qb * 128, mrow = (size_t)MR + 64 * b, hq = (size_t)(h * 2 + mp) * MP, hv0 = (size_t)(h * 2) * MP, hv1 = (size_t)(h * 2 + 1) * MP;
                ux.Q = QD + (hq + qrow) * 128; ux.Kr = KD + (hq + (size_t)b * SEQ) * 128; ux.Km = KD + (hq + mrow) * 128;
                ux.V0r = VD + (hv0 + (size_t)b * SEQ) * 128; ux.V0m = VD + (hv0 + mrow) * 128; ux.V1r = VD + (hv1 + (size_t)b * SEQ) * 128; ux.V1m = VD + (hv1 + mrow) * 128;
                ux.O = (mp ? O2 : O1) + qrow * 2048 + h * 256; ux.qb = qb; ux.nslope = -exp2f(-(float)(h + 1)); ux.kn2 = KN2 + ((h * 2 + mp) * 4 + b) * 65; ux.qst = QST + ((h * 2 + mp) * 4 + b) * 128;
                att::attn_unit_x<2048>(ux, (char*)lds, wave);
            } else { const int qb = code & 15, h = (code >> 4) & 15, b = (code >> 8) & 3;
                const size_t qrow = (size_t)b * SEQ + (size_t)qb * 256, mrow = (size_t)MR + 64 * b, hk = (size_t)(2 * h) * MP, hv = (size_t)(2 * h + 1) * MP;
                u.Q = QN + ((size_t)h * MR + qrow) * 128; u.Q2 = QR + ((size_t)h * MR + qrow) * 64;
                u.Kr = KV + (hk + (size_t)b * SEQ) * 128; u.Km = KV + (hk + mrow) * 128;
                u.K2r = KR + (size_t)b * SEQ * 64; u.K2m = KR + mrow * 64;
                u.Vr = KV + (hv + (size_t)b * SEQ) * 128; u.Vm = KV + (hv + mrow) * 128;
                u.O = OB + qrow * 2048 + h * 128; u.qb = qb; u.nslope2 = 0.f; u.kn2 = nullptr; u.qst = nullptr;
                att::attn_unit<true, false, 128, 64, 128, 128, 2048>(u, (char*)lds, wave); }
            if (tid == 0) qslot[0] = nxt_ < 3072u ? (unsigned)ATT_ORDER[nxt_] : 0xffffffffu;
        }
    }
    SEAM(4);
    if (IN(5)) for (int rep_ = 0; rep_ < REP(5); ++rep_) {
        float lam;
        { const float a = lq1[lane] * lk1[lane] + lq1[lane + 64] * lk1[lane + 64], c = lq2[lane] * lk2[lane] + lq2[lane + 64] * lk2[lane + 64];
          lam = __expf(wave_sum(a)) - __expf(wave_sum(c)) + LAMBDA_INIT; }
        f32x4 sl0 = *(const f32x4*)(subln + (lane & 31) * 8), sl1 = *(const f32x4*)(subln + (lane & 31) * 8 + 4);
        for (int m = gw; m < MR; m += NGW) {
            const v4u* p1 = (const v4u*)(O1 + (size_t)m * 2048) + lane; const v4u* p2 = (const v4u*)(O2 + (size_t)m * 2048) + lane;
            const v4u* pg = (const v4u*)(GD + (size_t)m * 2048) + lane;
            const v4u* pb = (const v4u*)(OB + (size_t)m * 2048) + lane; const v4u* pm = (const v4u*)(GM + (size_t)m * 2048) + lane;
            v4u a[4], b[4], gt[4], ab[4], gm[4];
#pragma unroll
            for (int j = 0; j < 4; ++j) { a[j] = p1[64 * j]; b[j] = p2[64 * j]; gt[j] = pg[64 * j]; ab[j] = pb[64 * j]; gm[j] = pm[64 * j]; }
            v4u* po = (v4u*)(MIX + (size_t)m * 4096) + lane;
#pragma unroll
            for (int j = 0; j < 4; ++j) { float d[8]; float ss = 0.f;
#pragma unroll
                for (int e = 0; e < 4; ++e) { const float d0 = bflo(a[j][e]) - lam * bflo(b[j][e]), d1 = bfhi(a[j][e]) - lam * bfhi(b[j][e]); d[2 * e] = d0; d[2 * e + 1] = d1; ss += d0 * d0 + d1 * d1; }
                ss += __shfl_xor(ss, 1); ss += __shfl_xor(ss, 2); ss += __shfl_xor(ss, 4); ss += __shfl_xor(ss, 8); ss += __shfl_xor(ss, 16);
                const float rstd = (1.f - LAMBDA_INIT) / sqrtf(ss * (1.f / 256.f) + RMS_EPS); v4u o;
#pragma unroll
                for (int e = 0; e < 4; ++e) { const f32x4 s4 = (e >> 1) ? sl1 : sl0;
                    o[e] = pk2(d[2 * e] * rstd * s4[(e & 1) * 2] * silu(bflo(gt[j][e])), d[2 * e + 1] * rstd * s4[(e & 1) * 2 + 1] * silu(bfhi(gt[j][e]))); }
                po[64 * j] = o;
                v4u o2;
#pragma unroll
                for (int e = 0; e < 4; ++e) o2[e] = pk2(bflo(ab[j][e]) * silu(bflo(gm[j][e])), bfhi(ab[j][e]) * silu(bfhi(gm[j][e])));
                po[256 + 64 * j] = o2; }
        }
    }
    SEAM(5);
    if (IN(6)) for (int rep_ = 0; rep_ < REP(6); ++rep_) {
        pg8::Gemm g{MIX, Wt_out, MR, 4096, 4096}; pg8::StaticOrder S; S.init(MR, 4096, G, bx);
        pg8::EpiBf16<0> E{Y16, 4096, nullptr, 0, 0, 1.f};
        pg8::gemm_phase<pg8::EpiBf16<0>, pg8::StaticOrder, false, true>((LAS unsigned char*)lds, g, S, E, wave);
    }
    SEAM(6);
    if (IN(7)) {
        for (int m = gw; m < MR; m += NGW) {
            const v4u* yr = (const v4u*)(Y16 + (size_t)m * D_MODEL) + lane; f32x4* orow = (f32x4*)(out + (size_t)m * D_MODEL) + 2 * lane;
            const f32x4* xr = (const f32x4*)(x + (size_t)m * D_MODEL) + 2 * lane; const f32x4* gr = (const f32x4*)g_post + 2 * lane;
            v4u v[8]; float s = 0.f;
#pragma unroll
            for (int j = 0; j < 8; ++j) { v[j] = yr[64 * j];
#pragma unroll
                for (int e = 0; e < 4; ++e) { const float a = bflo(v[j][e]), b = bfhi(v[j][e]); s += a * a + b * b; } }
            const float rstd = 1.f / sqrtf(wave_sum(s) * (1.f / D_MODEL) + RMS_EPS);
#pragma unroll
            for (int j = 0; j < 8; ++j) { const f32x4 g0 = gr[128 * j], g1 = gr[128 * j + 1], x0 = __builtin_nontemporal_load(xr + 128 * j), x1 = __builtin_nontemporal_load(xr + 128 * j + 1);
                f32x4 y0 = {bflo(v[j][0]), bfhi(v[j][0]), bflo(v[j][1]), bfhi(v[j][1])}, y1 = {bflo(v[j][2]), bfhi(v[j][2]), bflo(v[j][3]), bfhi(v[j][3])};
                __builtin_nontemporal_store(x0 + y0 * rstd * g0, orow + 128 * j); __builtin_nontemporal_store(x1 + y1 * rstd * g1, orow + 128 * j + 1); }
        }
    }
#undef IN
#undef SEAM
#undef lane
#undef tid
}

extern "C" void kernel_launch(void* const* d_in, const int* in_sizes, int n_in, void* d_out, int out_size, void* d_ws, size_t ws_size, hipStream_t stream) {
    static int grid = 0;
    if (grid == 0) {
        if (n_in != 15 || out_size != MR * D_MODEL || ws_size < WS_END) { fprintf(stderr, "kernel_launch: unexpected shapes (n_in %d out %d ws %zu)\n", n_in, out_size, ws_size); grid = -1; return; }
        int dev = 0, cus = 0, per_cu = 0;
        (void)hipGetDevice(&dev); (void)hipDeviceGetAttribute(&cus, hipDeviceAttributeMultiprocessorCount, dev);
        if (hipFuncSetAttribute((const void*)hybrid_fwd, hipFuncAttributeMaxDynamicSharedMemorySize, LDS_BYTES) != hipSuccess) { fprintf(stderr, "kernel_launch: hipFuncSetAttribute failed\n"); grid = -1; return; }
        if (hipOccupancyMaxActiveBlocksPerMultiprocessor(&per_cu, (const void*)hybrid_fwd, NWAVES * 64, LDS_BYTES) != hipSuccess || per_cu < 1) per_cu = 1;
        (void)hipGetLastError();
        grid = cus * per_cu;
    }
    if (grid < 0) return;
    if (hipMemsetAsync((char*)d_ws + WS_CTL, 0, CTL_ZERO_BYTES, stream) != hipSuccess) { fprintf(stderr, "kernel_launch: memset failed\n"); return; }
    Args a{};
    for (int i = 0; i < 15; ++i) a.in[i] = (const float*)d_in[i];
    a.out = (float*)d_out; a.ws = (unsigned char*)d_ws; a.ph_lo = 0; a.ph_hi = 8;
    void* kargs[] = {&a};
    hipError_t e = hipLaunchCooperativeKernel((const void*)hybrid_fwd, dim3(grid), dim3(NWAVES * 64), kargs, LDS_BYTES, stream);
    if (e != hipSuccess) fprintf(stderr, "kernel_launch: cooperative launch failed: %s (grid %d)\n", hipGetErrorString(e), grid);
}
```

```cpp
#include <hip/hip_runtime.h>
#include <hip/hip_cooperative_groups.h>
#include <cstdio>
#include <cstdint>
namespace cg = cooperative_groups;
namespace pg8 {
#define PG8_LAS __attribute__((address_space(3)))
typedef unsigned short bf16_t;
typedef short bf16x8 __attribute__((ext_vector_type(8)));
typedef float f32x4 __attribute__((ext_vector_type(4)));
typedef unsigned u32x4 __attribute__((ext_vector_type(4)));
constexpr int BM = 256, BK = 64, HALF = 128, HTB = HALF * BK * 2  , STAGE_BYTES = 8 * HTB, NXCD = 8, WGM = 8;

__host__ __device__ __forceinline__ int lds_byte(int r, int c) { const int st = (r >> 4) * 2 + (c >> 5), rr = r & 15, cc = c & 31, ob = rr * 64 + cc * 2; return st * 1024 + (ob ^ (((ob >> 9) & 1) << 5)); }
__host__ __device__ __forceinline__ void stage_rc(int b, int& R, int& C) { const int st = b / 1024, sb = b % 1024, swz = sb ^ (((sb >> 9) & 1) << 5); R = (st >> 1) * 16 + swz / 64; C = (st & 1) * 32 + (swz % 64) / 2; }
__host__ __device__ __forceinline__ int perm32(int rho) { const int n = rho >> 4, i = rho & 15; return 8 * (i >> 2) + 4 * n + (i & 3); }

struct Unit { int pm, pn; };
struct Gemm { const bf16_t* A; const bf16_t* Bt; int M, N, K; };

struct StaticOrder {
    int nM, nN, nwg, G, c;
    __host__ __device__ void init(int M, int N, int G_, int c_) { nM = M / BM; nN = N / BM; nwg = nM * nN; G = G_; c = c_; }
    __host__ __device__ bool next(int i, Unit& u) const {
        const long L = (long)i * G + c; if (L >= nwg) return false;
        int wgid = (int)L; { const int q = nwg / NXCD, r = nwg % NXCD, xcd = wgid % NXCD, off = wgid / NXCD; wgid = (xcd < r ? xcd * (q + 1) : r * (q + 1) + (xcd - r) * q) + off; }
        const int nig = WGM * nN, gid = wgid / nig, fm = gid * WGM, gsz = (nM - fm) < WGM ? (nM - fm) : WGM;
        u.pm = fm + ((wgid % nig) % gsz); u.pn = (wgid % nig) / gsz; return true;
    }
    __device__ __forceinline__ void a_ready(const Unit&) const {}
    __device__ __forceinline__ void done(const Unit&) const {}
};

__device__ __forceinline__ unsigned cvt_pk_bf16(float lo, float hi) { unsigned r; asm volatile("v_cvt_pk_bf16_f32 %0, %1, %2" : "=v"(r) : "v"(lo), "v"(hi)); return r; }
typedef float f32x2 __attribute__((ext_vector_type(2)));
__device__ __forceinline__ f32x2 gelu_pk(f32x2 v) {
    const f32x2 av = __builtin_elementwise_abs(v), d = av * 0.2316418882f + 1.0f;
    f32x2 t; t.x = __builtin_amdgcn_rcpf(d.x); t.y = __builtin_amdgcn_rcpf(d.y);
    f32x2 q = t * 0.5307027145f + (-0.7265760135f); q = q * t + 0.7107068705f; q = q * t + (-0.142248368f); q = q * t + 0.127414796f; q = q * t;
    const f32x2 s = (v * v) * (-0.72134752044f);
    f32x2 e; e.x = __builtin_amdgcn_exp2f(s.x); e.y = __builtin_amdgcn_exp2f(s.y);
    const f32x2 m = v * (q * e), r = v - m;
    f32x2 o; o.x = v.x < 0.f ? m.x : r.x; o.y = v.y < 0.f ? m.y : r.y; return o;
}

template <int ACT  > struct EpiBf16 {
    static constexpr bool PERM = true, AFTER_DRAIN = false; static_assert(ACT == 0 || ACT == 1, "EpiBf16: ACT is 0 (none) or 1 (gelu_pk)");
    bf16_t* O; int ldc; const float* bias; int split_cols; size_t split_stride; float scale0;
    __device__ __forceinline__ void operator()(const f32x4 (&acc)[2][2][4][2], const Unit& u, int wr, int wc, int fr, int fq) const {
        const int row0 = u.pm * BM + wr * 64 + fr; int colt = u.pn * BM; bf16_t* base = O;
        float sc = 1.f; if (split_cols) { const int t = colt / split_cols; base += (size_t)t * split_stride; colt -= t * split_cols; if (t == 0) sc = scale0; }
        const int col0 = colt + wc * 32 + 8 * fq, bcol0 = u.pn * BM + wc * 32 + 8 * fq;
        f32x4 bv[2][2];
#pragma unroll
        for (int bj = 0; bj < 2; ++bj)
#pragma unroll
            for (int n = 0; n < 2; ++n) bv[bj][n] = bias ? *(const f32x4*)(bias + bcol0 + bj * HALF + 4 * n) : (f32x4){0.f, 0.f, 0.f, 0.f};
#pragma unroll
        for (int ai = 0; ai < 2; ++ai)
#pragma unroll
            for (int m = 0; m < 4; ++m) { bf16_t* rowp = base + (size_t)(row0 + ai * HALF + m * 16) * ldc + col0;
#pragma unroll
                for (int bj = 0; bj < 2; ++bj) { f32x4 v0 = acc[ai][bj][m][0] + bv[bj][0], v1 = acc[ai][bj][m][1] + bv[bj][1];
                    if (ACT == 1) { f32x2 a = gelu_pk((f32x2){v0[0], v0[1]}), b = gelu_pk((f32x2){v0[2], v0[3]}), c = gelu_pk((f32x2){v1[0], v1[1]}), d = gelu_pk((f32x2){v1[2], v1[3]});
                        v0 = (f32x4){a.x, a.y, b.x, b.y}; v1 = (f32x4){c.x, c.y, d.x, d.y}; }
                    v0 = v0 * sc; v1 = v1 * sc; u32x4 w; w.x = cvt_pk_bf16(v0[0], v0[1]); w.y = cvt_pk_bf16(v0[2], v0[3]); w.z = cvt_pk_bf16(v1[0], v1[1]); w.w = cvt_pk_bf16(v1[2], v1[3]);
                    *(u32x4*)(rowp + bj * HALF) = w; } }
    }
};
__device__ __forceinline__ u32x4 pack8s(f32x4 v0, f32x4 v1, float sc) {
    v0 = v0 * sc; v1 = v1 * sc; u32x4 w; w.x = cvt_pk_bf16(v0[0], v0[1]); w.y = cvt_pk_bf16(v0[2], v0[3]); w.z = cvt_pk_bf16(v1[0], v1[1]); w.w = cvt_pk_bf16(v1[2], v1[3]); return w;
}
__device__ __forceinline__ u32x4 rope8(f32x4 v0, f32x4 v1, const float* cosT, const float* sinT, int pos, int i0, float sc) {
    const f32x4 cs = *(const f32x4*)(cosT + pos * 32 + i0), sn = *(const f32x4*)(sinT + pos * 32 + i0);
    f32x4 a, b;
    a[0] = v0[0] * cs[0] - v0[1] * sn[0]; a[1] = v0[0] * sn[0] + v0[1] * cs[0];
    a[2] = v0[2] * cs[1] - v0[3] * sn[1]; a[3] = v0[2] * sn[1] + v0[3] * cs[1];
    b[0] = v1[0] * cs[2] - v1[1] * sn[2]; b[1] = v1[0] * sn[2] + v1[1] * cs[2];
    b[2] = v1[2] * cs[3] - v1[3] * sn[3]; b[3] = v1[2] * sn[3] + v1[3] * cs[3];
    return pack8s(a, b, sc);
}
struct EpiZ {
    static constexpr bool PERM = true, AFTER_DRAIN = false;
    static constexpr size_t MPR = 16640;
    bf16_t *QD, *KD, *VD, *GD, *CQ, *CKV, *GM, *KR; const float* cosT; const float* sinT; float scq;
    __device__ __forceinline__ void operator()(const f32x4 (&acc)[2][2][4][2], const Unit& u, int wr, int wc, int fr, int fq) const {
        const int colt = u.pn * BM; bf16_t* base; int ldc, c0; float sc = 1.f; bool rope = false;
        bool hm = false;
        if (colt < 2048) { base = QD + (size_t)(colt >> 8) * 2 * MPR * 128; hm = true; sc = scq; ldc = 128; c0 = 0; }
        else if (colt < 4096) { base = KD + (size_t)((colt - 2048) >> 8) * 2 * MPR * 128; hm = true; ldc = 128; c0 = 0; }
        else if (colt < 6144) { base = VD + (size_t)((colt - 4096) >> 8) * 2 * MPR * 128; hm = true; ldc = 128; c0 = 0; }
        else if (colt < 8192) { base = GD; ldc = 2048; c0 = colt - 6144; }
        else if (colt < 9728) { base = CQ; ldc = 1536; c0 = colt - 8192; }
        else if (colt < 10240) { base = CKV; ldc = 512; c0 = colt - 9728; }
        else if (colt < 12288) { base = GM; ldc = 2048; c0 = colt - 10240; }
        else { base = KR; ldc = 64; c0 = 0; rope = true; }
        const int row0 = u.pm * BM + wr * 64 + fr, lc = wc * 32 + 8 * fq;
        if (!rope) {
#pragma unroll
            for (int ai = 0; ai < 2; ++ai)
#pragma unroll
                for (int m = 0; m < 4; ++m) { bf16_t* rowp = base + (size_t)(row0 + ai * HALF + m * 16) * ldc + c0 + lc;
#pragma unroll
                    for (int bj = 0; bj < 2; ++bj) *(u32x4*)(rowp + (hm ? (size_t)bj * MPR * 128 : (size_t)(bj * HALF))) = pack8s(acc[ai][bj][m][0], acc[ai][bj][m][1], sc); }
        } else if (wc < 2) {
#pragma unroll
            for (int ai = 0; ai < 2; ++ai)
#pragma unroll
                for (int m = 0; m < 4; ++m) { const int row = row0 + ai * HALF + m * 16; const int pos = row < 16384 ? 16 + (row & 4095) : ((row - 16384) & 63);
                    *(u32x4*)(base + (size_t)row * 64 + lc) = rope8(acc[ai][0][m][0], acc[ai][0][m][1], cosT, sinT, pos, lc >> 1, 1.f); }
        }
    }
};
struct EpiQ {
    static constexpr bool PERM = true, AFTER_DRAIN = false;
    bf16_t *QN, *QR; const float* cosT; const float* sinT; float sc;
    __device__ __forceinline__ void operator()(const f32x4 (&acc)[2][2][4][2], const Unit& u, int wr, int wc, int fr, int fq) const {
        const int colt = u.pn * BM; const int row0 = u.pm * BM + wr * 64 + fr, lc = wc * 32 + 8 * fq;
        if (colt < 2048) {
#pragma unroll
            for (int ai = 0; ai < 2; ++ai)
#pragma unroll
                for (int m = 0; m < 4; ++m) { bf16_t* rowp = QN + ((size_t)(2 * u.pn) * 16384 + (size_t)(row0 + ai * HALF + m * 16)) * 128 + lc;
#pragma unroll
                    for (int bj = 0; bj < 2; ++bj) *(u32x4*)(rowp + (size_t)bj * 16384 * 128) = pack8s(acc[ai][bj][m][0], acc[ai][bj][m][1], sc); }
        } else {
            const int c0 = colt - 2048;
#pragma unroll
            for (int ai = 0; ai < 2; ++ai)
#pragma unroll
                for (int m = 0; m < 4; ++m) { const int row = row0 + ai * HALF + m * 16; const int pos = 16 + (row & 4095);
#pragma unroll
                    for (int bj = 0; bj < 2; ++bj) { const int cl = c0 + bj * HALF + lc;
                        *(u32x4*)(QR + ((size_t)(cl >> 6) * 16384 + row) * 64 + (cl & 63)) = rope8(acc[ai][bj][m][0], acc[ai][bj][m][1], cosT, sinT, pos, (cl & 63) >> 1, sc); } }
        }
    }
};
struct EpiKV {
    static constexpr bool PERM = true, AFTER_DRAIN = false;
    bf16_t* KVh;
    __device__ __forceinline__ void operator()(const f32x4 (&acc)[2][2][4][2], const Unit& u, int wr, int wc, int fr, int fq) const {
        const int row0 = u.pm * BM + wr * 64 + fr, lc = wc * 32 + 8 * fq;
#pragma unroll
        for (int ai = 0; ai < 2; ++ai)
#pragma unroll
            for (int m = 0; m < 4; ++m) { bf16_t* rowp = KVh + ((size_t)(2 * u.pn) * 16640 + (size_t)(row0 + ai * HALF + m * 16)) * 128 + lc;
#pragma unroll
                for (int bj = 0; bj < 2; ++bj) *(u32x4*)(rowp + (size_t)bj * 16640 * 128) = pack8s(acc[ai][bj][m][0], acc[ai][bj][m][1], 1.f); }
    }
};
struct EpiY {
    static constexpr bool PERM = true, AFTER_DRAIN = false;
    float* Y; int ldc;
    __device__ __forceinline__ void operator()(const f32x4 (&acc)[2][2][4][2], const Unit& u, int wr, int wc, int fr, int fq) const {
        const int row0 = u.pm * BM + wr * 64 + fr, col0 = u.pn * BM + wc * 32 + 8 * fq;
#pragma unroll
        for (int ai = 0; ai < 2; ++ai)
#pragma unroll
            for (int m = 0; m < 4; ++m) { float* rowp = Y + (size_t)(row0 + ai * HALF + m * 16) * ldc + col0;
#pragma unroll
                for (int bj = 0; bj < 2; ++bj) { *(f32x4*)(rowp + bj * HALF) = acc[ai][bj][m][0]; *(f32x4*)(rowp + bj * HALF + 4) = acc[ai][bj][m][1]; } }
    }
};

template <class Epi, class Sched, bool ALIGN_EPI = false, bool SP2 = false>
__device__ __forceinline__ void gemm_phase(PG8_LAS unsigned char* lds, const Gemm g, const Sched& S, const Epi& E, const int wid_arg) {
    const int wid = wid_arg, lane = (int)__builtin_amdgcn_mbcnt_hi(~0u, __builtin_amdgcn_mbcnt_lo(~0u, 0u)), tid = wid * 64 + lane, wr = wid >> 2, wc = wid & 3, fr = lane & 15, fq = lane >> 4;
    const int K = g.K, nt = K / BK;
    unsigned voffA[2], voffB[2];
#pragma unroll
    for (int i = 0; i < 2; ++i) { int R, C; stage_rc(tid * 16 + i * 8192, R, C); const int Rb = Epi::PERM ? ((R & ~31) + perm32(R & 31)) : R;
        voffA[i] = (unsigned)(R * K + C) * 2u; voffB[i] = (unsigned)(Rb * K + C) * 2u; }
    const size_t kstep = (size_t)(BK * 2);
    const size_t hstep = (size_t)HALF * K * 2;
    const size_t tstep = 2 * hstep;
    const unsigned ldsw = (unsigned)wid * 1024u;
    const int aoff = lds_byte(wr * 64 + fr, fq * 8), boff = lds_byte(wc * 32 + fr, fq * 8);
#define PG8_SA(b, h) (((b) * 2 + (h)) * HTB)
#define PG8_SB(b, h) ((4 + (b) * 2 + (h)) * HTB)
#define PG8_STAGE(bufoff, gbase, voff) do { _Pragma("unroll") for (int _i = 0; _i < 2; ++_i) \
        __builtin_amdgcn_global_load_lds((const unsigned*)((const char*)(gbase) + (voff)[_i]), (PG8_LAS unsigned*)(lds + (bufoff) + ldsw + _i * 8192), 16, 0, 0); } while (0)
#define PG8_LDA(dst, b, h) do { _Pragma("unroll") for (int m = 0; m < 4; ++m) _Pragma("unroll") for (int k = 0; k < 2; ++k) dst[m][k] = *(const PG8_LAS bf16x8*)(lds + PG8_SA(b, h) + aoff + m * 2048 + k * 1024); } while (0)
#define PG8_LDB(dst, b, h) do { _Pragma("unroll") for (int n = 0; n < 2; ++n) _Pragma("unroll") for (int k = 0; k < 2; ++k) dst[n][k] = *(const PG8_LAS bf16x8*)(lds + PG8_SB(b, h) + boff + n * 2048 + k * 1024); } while (0)
#define PG8_MMA(ai, bj, At, Bt) do { __builtin_amdgcn_s_setprio(1); _Pragma("unroll") for (int m = 0; m < 4; ++m) _Pragma("unroll") for (int n = 0; n < 2; ++n) _Pragma("unroll") for (int k = 0; k < 2; ++k) \
        acc[ai][bj][m][n] = __builtin_amdgcn_mfma_f32_16x16x32_bf16(Bt[n][k], At[m][k], acc[ai][bj][m][n], 0, 0, 0); __builtin_amdgcn_s_setprio(0); } while (0)
#define PG8_WAIT_V(n) asm volatile("s_waitcnt vmcnt(" #n ")" ::: "memory")
#define PG8_WAIT_L(n) asm volatile("s_waitcnt lgkmcnt(" #n ")" ::: "memory")
#define PG8_BAR __builtin_amdgcn_s_barrier()
#define PG8_SCHED __builtin_amdgcn_sched_barrier(0)
    Unit cur, nxt; int ui = 0;
    if (!S.next(0, cur)) return;
    f32x4 acc[2][2][4][2];
#pragma unroll
    for (int a = 0; a < 2; ++a)
#pragma unroll
        for (int b = 0; b < 2; ++b)
#pragma unroll
            for (int m = 0; m < 4; ++m)
#pragma unroll
                for (int n = 0; n < 2; ++n) acc[a][b][m][n] = (f32x4){0.f, 0.f, 0.f, 0.f};
    bf16x8 At[4][2], B0[2][2], B1[2][2];
    const char* cA = (const char*)g.A + (size_t)cur.pm * tstep; const char* cB = (const char*)g.Bt + (size_t)cur.pn * tstep;
    S.a_ready(cur);
    if constexpr (SP2) {
        PG8_STAGE(PG8_SB(0, 0), cB, voffB); PG8_STAGE(PG8_SB(0, 1), cB + hstep, voffB); PG8_STAGE(PG8_SA(0, 0), cA, voffA); PG8_STAGE(PG8_SA(0, 1), cA + hstep, voffA);
        if (wr == 1) PG8_BAR;
        PG8_WAIT_V(2); PG8_BAR;
        PG8_STAGE(PG8_SB(1, 0), cB + kstep, voffB); PG8_STAGE(PG8_SA(1, 0), cA + kstep, voffA); PG8_STAGE(PG8_SB(1, 1), cB + hstep + kstep, voffB);
        PG8_WAIT_V(6); PG8_BAR;
    } else {
        PG8_STAGE(PG8_SB(0, 0), cB, voffB); PG8_STAGE(PG8_SA(0, 0), cA, voffA); PG8_STAGE(PG8_SB(0, 1), cB + hstep, voffB); PG8_STAGE(PG8_SA(0, 1), cA + hstep, voffA);
        if (wr == 1) PG8_BAR;
        PG8_WAIT_V(4); PG8_BAR;
        PG8_STAGE(PG8_SB(1, 0), cB + kstep, voffB); PG8_STAGE(PG8_SA(1, 0), cA + kstep, voffA); PG8_STAGE(PG8_SB(1, 1), cB + hstep + kstep, voffB);
        PG8_WAIT_V(6); PG8_BAR;
    }
    for (;;) {
        const bool has_next = S.next(ui + 1, nxt);
        const char* nA = has_next ? (const char*)g.A + (size_t)nxt.pm * tstep : cA; const char* nB = has_next ? (const char*)g.Bt + (size_t)nxt.pn * tstep : cB;
        for (int t = 0; t < nt; t += 2) {
            const bool last = (t == nt - 2);
            const char* a1 = cA + (size_t)(t + 1) * kstep;
            const char* a2 = last ? nA : cA + (size_t)(t + 2) * kstep; const char* b2 = last ? nB : cB + (size_t)(t + 2) * kstep;
            const char* a3 = a2 + kstep; const char* b3 = b2 + kstep;
            if (last && has_next) S.a_ready(nxt);
            if constexpr (SP2) {
            PG8_LDB(B0, 0, 0); PG8_LDB(B1, 0, 1); PG8_SCHED; PG8_LDA(At, 0, 0); PG8_STAGE(PG8_SA(1, 1), a1 + hstep, voffA);
            PG8_WAIT_V(8); PG8_WAIT_L(0); PG8_BAR; PG8_MMA(0, 0, At, B0); PG8_MMA(0, 1, At, B1); PG8_BAR; PG8_SCHED;
            PG8_LDA(At, 0, 1); PG8_STAGE(PG8_SB(0, 0), b2, voffB); PG8_STAGE(PG8_SB(0, 1), b2 + hstep, voffB); PG8_STAGE(PG8_SA(0, 0), a2, voffA);
            PG8_WAIT_V(8); PG8_WAIT_L(0); PG8_BAR; PG8_MMA(1, 0, At, B0); PG8_MMA(1, 1, At, B1); PG8_BAR; PG8_SCHED;
            PG8_LDB(B0, 1, 0); PG8_LDB(B1, 1, 1); PG8_SCHED; PG8_LDA(At, 1, 0); PG8_STAGE(PG8_SA(0, 1), a2 + hstep, voffA);
            PG8_WAIT_V(8); PG8_WAIT_L(0); PG8_BAR; PG8_MMA(0, 0, At, B0); PG8_MMA(0, 1, At, B1); PG8_BAR; PG8_SCHED;
            PG8_LDA(At, 1, 1); PG8_STAGE(PG8_SB(1, 0), b3, voffB); PG8_STAGE(PG8_SB(1, 1), b3 + hstep, voffB); PG8_STAGE(PG8_SA(1, 0), a3, voffA);
            PG8_WAIT_V(8); PG8_WAIT_L(0); PG8_BAR; PG8_MMA(1, 0, At, B0); PG8_MMA(1, 1, At, B1); PG8_BAR; PG8_SCHED;
            } else {
            PG8_LDB(B0, 0, 0); PG8_SCHED; PG8_LDA(At, 0, 0); PG8_STAGE(PG8_SA(1, 1), a1 + hstep, voffA);
            PG8_WAIT_L(8); PG8_BAR; PG8_WAIT_L(0); PG8_MMA(0, 0, At, B0); PG8_BAR; PG8_SCHED;
            PG8_LDB(B1, 0, 1); PG8_STAGE(PG8_SB(0, 0), b2, voffB);
            PG8_BAR; PG8_WAIT_L(0); PG8_MMA(0, 1, At, B1); PG8_BAR;
            PG8_LDA(At, 0, 1); PG8_STAGE(PG8_SA(0, 0), a2, voffA);
            PG8_BAR; PG8_WAIT_L(0); PG8_MMA(1, 0, At, B0); PG8_BAR; PG8_SCHED;
            PG8_STAGE(PG8_SB(0, 1), b2 + hstep, voffB);
            PG8_WAIT_V(6); PG8_BAR; PG8_MMA(1, 1, At, B1); PG8_BAR;
            PG8_LDB(B0, 1, 0); PG8_SCHED; PG8_LDA(At, 1, 0); PG8_STAGE(PG8_SA(0, 1), a2 + hstep, voffA);
            PG8_WAIT_L(8); PG8_BAR; PG8_WAIT_L(0); PG8_MMA(0, 0, At, B0); PG8_BAR; PG8_SCHED;
            PG8_LDB(B1, 1, 1); PG8_STAGE(PG8_SB(1, 0), b3, voffB);
            PG8_BAR; PG8_WAIT_L(0); PG8_MMA(0, 1, At, B1); PG8_BAR;
            PG8_LDA(At, 1, 1); PG8_STAGE(PG8_SA(1, 0), a3, voffA);
            PG8_BAR; PG8_WAIT_L(0); PG8_MMA(1, 0, At, B0); PG8_BAR; PG8_SCHED;
            PG8_STAGE(PG8_SB(1, 1), b3 + hstep, voffB);
            PG8_WAIT_V(6); PG8_BAR; PG8_MMA(1, 1, At, B1); PG8_BAR;
            }
        }
        if constexpr (ALIGN_EPI) { if (wr == 0) PG8_BAR; }
        if constexpr (!Epi::AFTER_DRAIN) { E(acc, cur, wr, wc, fr, fq); S.done(cur); }
        if (!has_next) break;
#pragma unroll
        for (int a = 0; a < 2; ++a)
#pragma unroll
            for (int b = 0; b < 2; ++b)
#pragma unroll
                for (int m = 0; m < 4; ++m)
#pragma unroll
                    for (int n = 0; n < 2; ++n) acc[a][b][m][n] = (f32x4){0.f, 0.f, 0.f, 0.f};
        cur = nxt; cA = nA; cB = nB; ++ui;
        if constexpr (ALIGN_EPI) { if (wr == 1) PG8_BAR; }
    }
    PG8_WAIT_V(0);
    if constexpr (!ALIGN_EPI) { if (wr == 0) PG8_BAR; }
    PG8_BAR;
    if constexpr (Epi::AFTER_DRAIN) { E.fused(acc, cur, wr, wc, fr, fq, lds, wid, lane); S.done(cur); }
#undef PG8_SA
#undef PG8_SB
#undef PG8_STAGE
#undef PG8_LDA
#undef PG8_LDB
#undef PG8_MMA
#undef PG8_WAIT_V
#undef PG8_WAIT_L
#undef PG8_BAR
#undef PG8_SCHED
}
}
namespace att {
typedef unsigned short bf16_t;
typedef short bf16x8 __attribute__((ext_vector_type(8)));
typedef short s16x4 __attribute__((ext_vector_type(4)));
typedef float f32x16 __attribute__((ext_vector_type(16)));
typedef float f32x4 __attribute__((ext_vector_type(4)));
typedef unsigned u32x4 __attribute__((ext_vector_type(4)));
constexpr int NW = 8, QBLK = 32, KVBLK = 64, QB = NW * QBLK;
constexpr int SHM_V = KVBLK * 128 * 2, SHM_K = KVBLK * 128 * 2, SHM_K2 = KVBLK * 64 * 2;
constexpr int OFF_V = 0, OFF_K = 2 * SHM_V, OFF_K2 = OFF_K + 2 * SHM_K, OFF_WS = OFF_K2 + 2 * SHM_K2, OFF_Q2 = OFF_WS + NW * 64 * 4, LDS_BYTES = OFF_Q2 + NW * 4096;
constexpr float THR2 = 8.f * 1.4426950408889634f;
#define KSWZ(row, colB) ((row) * 256 + ((colB) ^ (((row) & 7) << 4)))
#define K2SWZ(row, colB) ((row) * 128 + ((colB) ^ ((((row) >> 1) & 7) << 4)))
#define SBAR() __builtin_amdgcn_sched_barrier(0)
__device__ __forceinline__ int v_st(int k, int c) { const int kk = (k & ~0xC) | ((k & 4) << 1) | ((k & 8) >> 1); return ((kk >> 3) * 4 + (c >> 5)) * 512 + ((kk & 7) * 32 + (c & 31)) * 2; }
__device__ __forceinline__ int v_rd_base(int lane) { return ((lane & 3) << 3) | (((lane >> 2) & 3) << 6) | (((lane >> 4) & 1) << 5) | (((lane >> 5) & 1) << 8); }
constexpr int v_rd_off(int d0, int ks, int half) { return d0 * 512 + ks * 4096 + half * 2048; }
__device__ __forceinline__ int crow(int r, int hi) { return (r & 3) + 8 * (r >> 2) + 4 * hi; }
__device__ __forceinline__ unsigned cvtpk(float lo, float hi) { unsigned r; asm volatile("v_cvt_pk_bf16_f32 %0, %1, %2" : "=v"(r) : "v"(lo), "v"(hi)); return r; }

template <bool NAT>
__device__ __forceinline__ void partialSM(f32x16& p0, f32x16& p1, float& m_reg, float& mn, float& alpha) {
    float pmax = p0[0]; for (int r = 1; r < 16; ++r) pmax = fmaxf(pmax, p0[r]); for (int r = 0; r < 16; ++r) pmax = fmaxf(pmax, p1[r]);
    { auto rr = __builtin_amdgcn_permlane32_swap(__float_as_uint(pmax), __float_as_uint(pmax), false, false);
      pmax = fmaxf(__uint_as_float(rr[0]), __uint_as_float(rr[1])); }
    constexpr float C2 = 1.4426950408889634f;
    if constexpr (NAT) {
        if (__builtin_expect(__all((pmax - m_reg) <= 8.f), 1)) { mn = m_reg; alpha = 1.f; }
        else { mn = fmaxf(m_reg, pmax); alpha = __builtin_amdgcn_exp2f((m_reg - mn) * C2); m_reg = mn; }
        const float mnL = -mn * C2;
        for (int r = 0; r < 16; ++r) p0[r] = fmaf(p0[r], C2, mnL); for (int r = 0; r < 16; ++r) p1[r] = fmaf(p1[r], C2, mnL);
    } else {
        if (__builtin_expect(__all((pmax - m_reg) <= THR2), 1)) { mn = m_reg; alpha = 1.f; }
        else { mn = fmaxf(m_reg, pmax); alpha = __builtin_amdgcn_exp2f(m_reg - mn); m_reg = mn; }
        for (int r = 0; r < 16; ++r) p0[r] = p0[r] - mn; for (int r = 0; r < 16; ++r) p1[r] = p1[r] - mn;
    }
    for (int r = 0; r < 16; ++r) p0[r] = __builtin_amdgcn_exp2f(p0[r]);
}
__device__ __forceinline__ void finishSM(f32x16& p0, f32x16& p1, float alpha, float& l_reg, bf16x8& pa0, bf16x8& pa1, bf16x8& pa2, bf16x8& pa3) {
    for (int r = 0; r < 16; ++r) p1[r] = __builtin_amdgcn_exp2f(p1[r]);
    float ps = 0; for (int r = 0; r < 16; ++r) ps += p0[r]; for (int r = 0; r < 16; ++r) ps += p1[r];
    { auto rr = __builtin_amdgcn_permlane32_swap(__float_as_uint(ps), __float_as_uint(ps), false, false);
      ps = __uint_as_float(rr[0]) + __uint_as_float(rr[1]); }
    l_reg = l_reg * alpha + ps;
#define PK4(P, B_, OUT) do { unsigned a0 = cvtpk(P[B_+0], P[B_+1]), a1 = cvtpk(P[B_+2], P[B_+3]);                          \
        unsigned b0 = cvtpk(P[B_+4], P[B_+5]), b1 = cvtpk(P[B_+6], P[B_+7]);                                             \
        auto r0 = __builtin_amdgcn_permlane32_swap(a0, b0, false, false); auto r1 = __builtin_amdgcn_permlane32_swap(a1, b1, false, false); \
        u32x4 w = {r0[0], r1[0], r0[1], r1[1]}; OUT = *reinterpret_cast<bf16x8*>(&w); } while (0)
    PK4(p0, 0, pa0); PK4(p0, 8, pa1); PK4(p1, 0, pa2); PK4(p1, 8, pa3);
#undef PK4
}
template <int KB, bool ROPE, bool AUG, bool QLDS = false>
__device__ __forceinline__ void qkt(f32x16& p0, f32x16& p1, const char* K_lds, const char* K2_lds, int r32, int hi, const bf16x8* qr, const char* q2l, bf16x8 ka0, bf16x8 ka1, bf16x8 qa) {
    p0 = f32x16{}; p1 = f32x16{};
    const char* kb[4];
#pragma unroll
    for (int dd = 0; dd < 4; ++dd) kb[dd] = K_lds + KB * SHM_K + KSWZ(r32, (dd * 16 + hi * 8) * 2);
#pragma unroll
    for (int d0 = 0; d0 < 8; ++d0) { const char* a = kb[d0 & 3] + (d0 >> 2) * 128;
        bf16x8 b0 = *reinterpret_cast<const bf16x8*>(a);
        bf16x8 b1 = *reinterpret_cast<const bf16x8*>(a + 32 * 256);
        bf16x8 qf; if (QLDS && d0 >= 6) qf = *reinterpret_cast<const bf16x8*>(q2l + (d0 - 6) * 1024); else qf = qr[d0];
        p0 = __builtin_amdgcn_mfma_f32_32x32x16_bf16(b0, qf, p0, 0, 0, 0);
        p1 = __builtin_amdgcn_mfma_f32_32x32x16_bf16(b1, qf, p1, 0, 0, 0); }
    if constexpr (ROPE) {
#pragma unroll
        for (int e = 0; e < 4; ++e) { const char* a = K2_lds + KB * SHM_K2 + K2SWZ(r32, (e * 2 + hi) * 16);
            bf16x8 b0 = *reinterpret_cast<const bf16x8*>(a);
            bf16x8 b1 = *reinterpret_cast<const bf16x8*>(a + 32 * 128);
            const bf16x8 q2 = *reinterpret_cast<const bf16x8*>(q2l + e * 1024);
            p0 = __builtin_amdgcn_mfma_f32_32x32x16_bf16(b0, q2, p0, 0, 0, 0);
            p1 = __builtin_amdgcn_mfma_f32_32x32x16_bf16(b1, q2, p1, 0, 0, 0); }
    }
    if constexpr (AUG) {
        p0 = __builtin_amdgcn_mfma_f32_32x32x16_bf16(ka0, qa, p0, 0, 0, 0);
        p1 = __builtin_amdgcn_mfma_f32_32x32x16_bf16(ka1, qa, p1, 0, 0, 0); }
}
template <int VB>
__device__ __forceinline__ void pv_tile(f32x16* o, int vb0, bf16x8 pa0, bf16x8 pa1, bf16x8 pa2, bf16x8 pa3) {
#define TRRD(dst, off) asm volatile("ds_read_b64_tr_b16 %0, %1 offset:%2" : "=&v"(dst) : "v"(vb0), "i"(off) : "memory")
#define PV_D0(d0) do { s16x4 l0, l1, l2, l3, h0, h1, h2, h3; constexpr int b_ = VB * SHM_V + v_rd_off(d0, 0, 0); \
        TRRD(l0, b_); TRRD(h0, b_ + 2048); TRRD(l1, b_ + 4096); TRRD(h1, b_ + 6144); TRRD(l2, b_ + 8192); TRRD(h2, b_ + 10240); TRRD(l3, b_ + 12288); TRRD(h3, b_ + 14336); \
        asm volatile("s_waitcnt lgkmcnt(0)" ::: "memory"); SBAR();   \
        o[d0] = __builtin_amdgcn_mfma_f32_32x32x16_bf16(pa0, (bf16x8){l0[0], l0[1], l0[2], l0[3], h0[0], h0[1], h0[2], h0[3]}, o[d0], 0, 0, 0);   \
        o[d0] = __builtin_amdgcn_mfma_f32_32x32x16_bf16(pa1, (bf16x8){l1[0], l1[1], l1[2], l1[3], h1[0], h1[1], h1[2], h1[3]}, o[d0], 0, 0, 0);   \
        o[d0] = __builtin_amdgcn_mfma_f32_32x32x16_bf16(pa2, (bf16x8){l2[0], l2[1], l2[2], l2[3], h2[0], h2[1], h2[2], h2[3]}, o[d0], 0, 0, 0);   \
        o[d0] = __builtin_amdgcn_mfma_f32_32x32x16_bf16(pa3, (bf16x8){l3[0], l3[1], l3[2], l3[3], h3[0], h3[1], h3[2], h3[3]}, o[d0], 0, 0, 0); } while (0)
    PV_D0(0); PV_D0(1); PV_D0(2); PV_D0(3);
#undef PV_D0
#undef TRRD
}
template <int OP>
__device__ __forceinline__ void store_o_tile(const f32x16* o, const float* rli, char* stg, bf16_t* Ow, int r32e, int hie, int lane2) {
#pragma unroll
    for (int hf = 0; hf < 2; ++hf) {
#pragma unroll
        for (int r = 0; r < 16; ++r) { const int orow = crow(r, hie);
#pragma unroll
            for (int d = 0; d < 2; ++d) { const float v = o[2 * hf + d][r] * rli[r]; *(unsigned short*)(stg + (orow * 64 + d * 32 + r32e) * 2) = (unsigned short)cvtpk(v, v); } }
        asm volatile("s_waitcnt lgkmcnt(0)" ::: "memory");
#pragma unroll
        for (int i = 0; i < 4; ++i) { const int row = i * 8 + (lane2 >> 3), ch = lane2 & 7; const u32x4 w = *(const u32x4*)(stg + (row * 64 + ch * 8) * 2);
            *(u32x4*)(Ow + (size_t)row * OP + hf * 64 + ch * 8) = w; }
        asm volatile("s_waitcnt lgkmcnt(0)" ::: "memory"); }
}
struct Unit {
    const bf16_t* Q;
    const bf16_t* Q2;
    const bf16_t* Kr; const bf16_t* Km;
    const bf16_t* K2r; const bf16_t* K2m;
    const bf16_t* Vr; const bf16_t* Vm;
    bf16_t* O;
    int qb; float nslope2;
    const float* kn2; const float* qst;
};
template <bool ROPE, bool ALIBI, int QP, int Q2P, int KP, int VP, int OP>
__device__ __forceinline__ void attn_unit(const Unit& u, char* lds, const int wid) {
    int lane; asm volatile("v_mbcnt_lo_u32_b32 %0, -1, 0\n\tv_mbcnt_hi_u32_b32 %0, -1, %0" : "=v"(lane));
    const int tid = wid * 64 + lane, r32 = lane & 31, hi = lane >> 5;
    int toff = 0;
    if constexpr (ALIBI) {
        const float* qs = u.qst + (4 * u.qb) * 2;
        const float qn2 = fmaxf(fmaxf(qs[0], qs[2]), fmaxf(qs[4], qs[6])), mlb = fminf(fminf(qs[1], qs[3]), fminf(qs[5], qs[7]));
        const int t = lane + 1, dmin = 256 * u.qb - 64 * t + 1;
        const bool inr = t < 4 * u.qb + 5 && dmin > 0;
        const float kn2v = inr ? u.kn2[t] : 0.f;
        const float ub = sqrtf(qn2 * kn2v) * 1.001f + 0.01f + u.nslope2 * (float)dmin;
        const unsigned long long bal = __ballot(inr && ub < mlb - 115.f);
        const int t_lo = 1 + __builtin_ctzll(~bal);
        toff = __builtin_amdgcn_readfirstlane((t_lo - 1) & ~1);
    }
    const int NT = 4 * u.qb + 5 - toff;
    const int jq = 1 + 4 * u.qb + (wid >> 1);
    char* V_lds = lds + OFF_V; char* K_lds = lds + OFF_K; char* K2_lds = lds + OFF_K2;
    float* ws = (float*)(lds + OFF_WS) + wid * 64; float* li_l = ws, * al_l = ws + 32;
    float m_reg = -1e30f, l_reg = 0; f32x16 o[4] = {};
    const int sr = tid >> 4, sc = (tid & 15) * 8, vst0 = v_st(sr, sc), vst1 = v_st(32 + sr, sc), kws = KSWZ(sr, sc * 2);
    const int sr2 = tid >> 3, sc2 = (tid & 7) * 8, k2ws = K2SWZ(sr2, sc2 * 2);
    const int vb0 = (int)(uintptr_t)V_lds + v_rd_base(lane);
    const unsigned vo0 = (unsigned)(sr * VP + sc) * 2u, vo1 = (unsigned)((32 + sr) * VP + sc) * 2u, ko0 = (unsigned)(sr * KP + sc) * 2u, ko1 = (unsigned)((32 + sr) * KP + sc) * 2u, k2o = (unsigned)(sr2 * 64 + sc2) * 2u;
    bf16x8 st_v0, st_v1, st_k0, st_k1, st_k2;
    bf16x8 qr[8]; const char* q2l = lds + OFF_Q2 + wid * 4096 + lane * 16;
#pragma unroll
    for (int d0 = 0; d0 < 8; ++d0) { const bf16x8 qv = *(const bf16x8*)(u.Q + (size_t)(wid * QBLK + r32) * QP + d0 * 16 + hi * 8);
        if (ALIBI && d0 >= 6) *(bf16x8*)(lds + OFF_Q2 + wid * 4096 + lane * 16 + (d0 - 6) * 1024) = qv; else qr[d0] = qv; }
    if constexpr (ROPE) {
#pragma unroll
        for (int e = 0; e < 4; ++e) *(bf16x8*)(lds + OFF_Q2 + wid * 4096 + lane * 16 + e * 1024) = *(const bf16x8*)(u.Q2 + (size_t)(wid * QBLK + r32) * Q2P + e * 16 + hi * 8);
    }
#define KT(t) ((t) == 0 ? u.Km : u.Kr + (size_t)(64 * ((t) + toff - 1)) * KP)
#define VT(t) ((t) == 0 ? u.Vm : u.Vr + (size_t)(64 * ((t) + toff - 1)) * VP)
#define K2T(t) ((t) == 0 ? u.K2m : u.K2r + (size_t)(64 * ((t) + toff - 1)) * 64)
#define VMW() asm volatile("s_waitcnt vmcnt(0)" ::: "memory")
#define SLOAD(t) do { const char* kt_ = (const char*)(KT(t)); const char* vt_ = (const char*)(VT(t));                         \
        st_v0 = *(const bf16x8*)(vt_ + vo0); st_v1 = *(const bf16x8*)(vt_ + vo1);                                               \
        st_k0 = *(const bf16x8*)(kt_ + ko0); st_k1 = *(const bf16x8*)(kt_ + ko1);                                               \
        if constexpr (ROPE) { st_k2 = *(const bf16x8*)((const char*)(K2T(t)) + k2o); } } while (0)
#define SWRITE_K(bf) do { *(bf16x8*)(K_lds + (bf) * SHM_K + kws) = st_k0; *(bf16x8*)(K_lds + (bf) * SHM_K + kws + 32 * 256) = st_k1;  \
        if constexpr (ROPE) { *(bf16x8*)(K2_lds + (bf) * SHM_K2 + k2ws) = st_k2; } } while (0)
#define SWRITE_V(bf) do { *(bf16x8*)(V_lds + (bf) * SHM_V + vst0) = st_v0; *(bf16x8*)(V_lds + (bf) * SHM_V + vst1) = st_v1; } while (0)
#define SWRITE(bf) do { SWRITE_V(bf); SWRITE_K(bf); } while (0)
#define RESC(a) do { if (__any((a) < 1.f)) { if (hi == 0) al_l[r32] = (a); asm volatile("s_waitcnt lgkmcnt(0)" ::: "memory");              \
                     for (int d_ = 0; d_ < 4; ++d_) for (int r = 0; r < 16; ++r) o[d_][r] *= al_l[crow(r, hi)]; } } while (0)
#define ACT(t) ((t) + toff <= jq)
    bf16x8 qa = {0, 0, 0, 0, 0, 0, 0, 0}; float n2s = 0.f;
    if constexpr (ALIBI) { const float sl = -u.nslope2;
        if (hi == 0) { const unsigned w0 = (__float_as_uint(64.f * sl) >> 16) | (__float_as_uint(sl) & 0xffff0000u), w1 = __float_as_uint(16.f * sl) >> 16;
            const u32x4 qw = {w0, w1, 0u, 0u}; qa = __builtin_bit_cast(bf16x8, qw);
            }
        n2s = -2.f * sl; }
#define KAUG(t, KA0, KA1) bf16x8 KA0 = {0, 0, 0, 0, 0, 0, 0, 0}, KA1 = KA0; if constexpr (ALIBI) { const int J_ = (t) == 0 ? -4 * u.qb : (t) + toff - 1 - 4 * u.qb;      \
        const unsigned jb_ = hi == 0 ? (__float_as_uint((float)J_) >> 16) : 0u, e3_ = (hi == 0 && (t) == 0) ? 0xbf80u : 0u;                                   \
        const unsigned cw0_ = hi == 0 ? (__float_as_uint((float)r32) & 0xffff0000u) : 0u, cw1_ = hi == 0 ? (__float_as_uint((float)(r32 + 32)) & 0xffff0000u) : 0u; \
        const u32x4 k0_ = {jb_ | cw0_, e3_, 0u, 0u}, k1_ = {jb_ | cw1_, e3_, 0u, 0u}; KA0 = __builtin_bit_cast(bf16x8, k0_); KA1 = __builtin_bit_cast(bf16x8, k1_); }
#define BIAS(P0_, P1_, t) do { if (!ACT(t)) { const float NEG_ = -__builtin_inff(); _Pragma("unroll") for (int r = 0; r < 16; ++r) { P0_[r] = NEG_; P1_[r] = NEG_; } }  \
      else if constexpr (ALIBI) { if ((t) + toff == jq) { float dqc = (float)(32 * (wid & 1) + r32 - 4 * hi); asm volatile("" : "+v"(dqc));                                                 \
        _Pragma("unroll") for (int r = 0; r < 16; ++r) { const float c_ = (float)((r & 3) + 8 * (r >> 2));                                                      \
            P0_[r] = fmaf(n2s, fmaxf(c_ - dqc, 0.f), P0_[r]); P1_[r] = fmaf(n2s, fmaxf(c_ + 32.f - dqc, 0.f), P1_[r]); } } } } while (0)
    f32x16 pA0, pA1, pB0, pB1; float mnA, mnB, alA, alB; bf16x8 pa0, pa1, pa2, pa3;
    if (wid >= 4) __builtin_amdgcn_s_setprio(1);
    SLOAD(0); VMW(); SWRITE(0); SBAR();
    SLOAD(1);
    __syncthreads();
    SBAR(); { KAUG(0, ka0_, ka1_); qkt<0, ROPE, ALIBI, ALIBI>(pA0, pA1, K_lds, K2_lds, r32, hi, qr, q2l, ka0_, ka1_, qa); }
    { const float NEG = -__builtin_inff();
#pragma unroll
      for (int r = 8; r < 16; ++r) pA0[r] = NEG;
#pragma unroll
      for (int r = 0; r < 16; ++r) pA1[r] = NEG; }
    BIAS(pA0, pA1, 0); partialSM<ALIBI>(pA0, pA1, m_reg, mnA, alA);
    VMW(); SWRITE(1);
    __syncthreads();
#define HALF_STEP(PX0, PX1, mnX, alX, PY0, PY1, alY, t, KB, VB, SB) do {                                                      \
        SBAR(); { KAUG(t, ka0_, ka1_); qkt<KB, ROPE, ALIBI, ALIBI>(PX0, PX1, K_lds, K2_lds, r32, hi, qr, q2l, ka0_, ka1_, qa); }             \
        finishSM(PY0, PY1, alY, l_reg, pa0, pa1, pa2, pa3); SBAR();                                                           \
        if ((t) + 1 < NT) { SLOAD((t) + 1); SBAR(); }                                                                         \
        pv_tile<VB>(o, vb0, pa0, pa1, pa2, pa3); BIAS(PX0, PX1, (t)); partialSM<ALIBI>(PX0, PX1, m_reg, mnX, alX);    \
        __syncthreads();                                                                                                      \
        if ((t) + 1 < NT) { VMW(); SWRITE(SB); }                                                                              \
        RESC(alX); __syncthreads(); } while (0)
    for (int t = 1; t + 1 < NT; t += 2) {
        HALF_STEP(pB0, pB1, mnB, alB, pA0, pA1, alA, t, 1, 0, 0);
        HALF_STEP(pA0, pA1, mnA, alA, pB0, pB1, alB, t + 1, 0, 1, 1);
    }
    finishSM(pA0, pA1, alA, l_reg, pa0, pa1, pa2, pa3); SBAR();
    pv_tile<0>(o, vb0, pa0, pa1, pa2, pa3);
    __builtin_amdgcn_s_setprio(0);
    int lane2; asm volatile("v_mbcnt_lo_u32_b32 %0, -1, 0\n\tv_mbcnt_hi_u32_b32 %0, -1, %0" : "=v"(lane2));
    const int r32e = lane2 & 31, hie = lane2 >> 5;
    if (hie == 0) li_l[r32e] = l_reg; asm volatile("s_waitcnt lgkmcnt(0)" ::: "memory");
    float rli[16];
#pragma unroll
    for (int r = 0; r < 16; ++r) rli[r] = __builtin_amdgcn_rcpf(li_l[crow(r, hie)]);
    store_o_tile<OP>(o, rli, lds + OFF_K + wid * 4096, u.O + (size_t)(wid * QBLK) * OP, r32e, hie, lane2);
    __syncthreads();
#undef KT
#undef VT
#undef K2T
#undef VMW
#undef SLOAD
#undef SWRITE_K
#undef SWRITE_V
#undef SWRITE
#undef RESC
#undef ACT
#undef BIAS
#undef KAUG
#undef HALF_STEP
}
typedef __attribute__((address_space(1))) const char* gcptr;
__device__ __forceinline__ gcptr sgpr_ptr(const char* p) {
    const unsigned long long v = (unsigned long long)p; const unsigned lo = (unsigned)__builtin_amdgcn_readfirstlane((int)(unsigned)v), hi = (unsigned)__builtin_amdgcn_readfirstlane((int)(unsigned)(v >> 32));
    return (gcptr)(((unsigned long long)hi << 32) | lo); }
struct UnitX {
    const bf16_t* Q;
    const bf16_t* Kr; const bf16_t* Km;
    const bf16_t* V0r; const bf16_t* V0m; const bf16_t* V1r; const bf16_t* V1m;
    bf16_t* O;
    int qb; float nslope;
    const float* kn2; const float* qst;
};
constexpr int XOFF_V = 0, XOFF_K = 65536, XOFF_P = 98304, XOFF_WS = 131072, XOFF_PS = XOFF_WS + 2048, XLDS_BYTES = XOFF_PS + 2048;
template <int OP>
__device__ __forceinline__ void attn_unit_x(const UnitX& u, char* lds, const int wid) {
    int lane; asm volatile("v_mbcnt_lo_u32_b32 %0, -1, 0\n\tv_mbcnt_hi_u32_b32 %0, -1, %0" : "=v"(lane));
    const int tid = wid * 64 + lane, r32 = lane & 31, hi = lane >> 5, g = wid & 3, vh = wid >> 2;
    int toff = 0;
    { const float* qs = u.qst + (2 * u.qb) * 2;
      const float qn2 = fmaxf(qs[0], qs[2]), mlb = fminf(qs[1], qs[3]);
      const int t = lane + 1, dmin = 128 * u.qb - 64 * t + 1;
      const bool inr = t < 2 * u.qb + 3 && dmin > 0;
      const float kn2v = inr ? u.kn2[t] : 0.f;
      float k1_ = 1.001f, k2_ = 115.01f; asm volatile("" : "+v"(k1_), "+v"(k2_));
      const float ub = sqrtf(qn2 * kn2v) * k1_ + u.nslope * (float)dmin;
      const unsigned long long bal = __ballot(inr && ub < mlb - k2_);
      const int t_lo = 1 + __builtin_ctzll(~bal);
      toff = __builtin_amdgcn_readfirstlane((t_lo - 1) & ~1); }
    const int NT = 2 * u.qb + 3 - toff;
    const int jq = 1 + 2 * u.qb + (g >> 1);
    char* K_lds = lds + XOFF_K; char* Vh_lds = lds + XOFF_V + vh * 32768;
    char* pbuf = lds + XOFF_P + g * 8192 + lane * 16;
    float* psc = (float*)(lds + XOFF_PS) + g * 128;
    float l_reg = 0.f; f32x16 o[4] = {};
    const int sr = tid >> 4, sc = (tid & 15) * 8, vst0 = v_st(sr, sc), vst1 = v_st(32 + sr, sc), kws = KSWZ(sr, sc * 2);
    const int vb0 = (int)(uintptr_t)Vh_lds + v_rd_base(lane);
    const unsigned so0 = (unsigned)(sr * 128 + sc) * 2u, so1 = (unsigned)((32 + sr) * 128 + sc) * 2u;
    bf16x8 st_k0, st_k1, st_a0, st_a1, st_b0, st_b1;
    bf16x8 qr[8];
#pragma unroll
    for (int d0 = 0; d0 < 8; ++d0) qr[d0] = *(const bf16x8*)(u.Q + (size_t)(g * QBLK + r32) * 128 + d0 * 16 + hi * 8);
    unsigned qw0s, qw1s; float n2s;
    { const float sl = -u.nslope;
      qw0s = (unsigned)__builtin_amdgcn_readfirstlane((int)((__float_as_uint(64.f * sl) >> 16) | (__float_as_uint(sl) & 0xffff0000u)));
      qw1s = (unsigned)__builtin_amdgcn_readfirstlane((int)(__float_as_uint(16.f * sl) >> 16)); n2s = -2.f * sl; }
#define XKT(t) ((const char*)((t) == 0 ? u.Km : u.Kr + (size_t)(64 * ((t) + toff - 1)) * 128))
#define XV0T(t) ((const char*)((t) == 0 ? u.V0m : u.V0r + (size_t)(64 * ((t) + toff - 1)) * 128))
#define XV1T(t) ((const char*)((t) == 0 ? u.V1m : u.V1r + (size_t)(64 * ((t) + toff - 1)) * 128))
#define XVMW() asm volatile("s_waitcnt vmcnt(0)" ::: "memory")
#define XLOAD_K(t) do { const gcptr p_ = sgpr_ptr(XKT(t)); st_k0 = *(const __attribute__((address_space(1))) bf16x8*)(p_ + so0); st_k1 = *(const __attribute__((address_space(1))) bf16x8*)(p_ + so1); } while (0)
#define XLOAD_V(t) do { const gcptr a_ = sgpr_ptr(XV0T(t)); const gcptr b_ = sgpr_ptr(XV1T(t)); st_a0 = *(const __attribute__((address_space(1))) bf16x8*)(a_ + so0); st_a1 = *(const __attribute__((address_space(1))) bf16x8*)(a_ + so1); st_b0 = *(const __attribute__((address_space(1))) bf16x8*)(b_ + so0); st_b1 = *(const __attribute__((address_space(1))) bf16x8*)(b_ + so1); } while (0)
#define XWRITE_K(bf) do { *(bf16x8*)(K_lds + (bf) * SHM_K + kws) = st_k0; *(bf16x8*)(K_lds + (bf) * SHM_K + kws + 32 * 256) = st_k1; } while (0)
#define XWRITE_V(bf) do { *(bf16x8*)(lds + XOFF_V + (bf) * SHM_V + vst0) = st_a0; *(bf16x8*)(lds + XOFF_V + (bf) * SHM_V + vst1) = st_a1;             \
        *(bf16x8*)(lds + XOFF_V + 32768 + (bf) * SHM_V + vst0) = st_b0; *(bf16x8*)(lds + XOFF_V + 32768 + (bf) * SHM_V + vst1) = st_b1; } while (0)
#define XACT(t) ((t) + toff <= jq)
#define XKAUG(t, KA0, KA1, QA) bf16x8 KA0, KA1, QA; { int hz_ = hi; asm volatile("" : "+v"(hz_));                                                       \
        const u32x4 qw_ = {hz_ == 0 ? qw0s : 0u, hz_ == 0 ? qw1s : 0u, 0u, 0u}; QA = __builtin_bit_cast(bf16x8, qw_);                                   \
        const int J_ = (t) == 0 ? -2 * u.qb : (t) + toff - 1 - 2 * u.qb;                                                                                \
        const unsigned jb_ = hz_ == 0 ? (__float_as_uint((float)J_) >> 16) : 0u, e3_ = (hz_ == 0 && (t) == 0) ? 0xbf80u : 0u;                            \
        const unsigned cw0_ = hz_ == 0 ? (__float_as_uint((float)r32) & 0xffff0000u) : 0u, cw1_ = hz_ == 0 ? (__float_as_uint((float)(r32 + 32)) & 0xffff0000u) : 0u; \
        const u32x4 k0_ = {jb_ | cw0_, e3_, 0u, 0u}, k1_ = {jb_ | cw1_, e3_, 0u, 0u}; KA0 = __builtin_bit_cast(bf16x8, k0_); KA1 = __builtin_bit_cast(bf16x8, k1_); }
#define XQKT(t, KB) do { XKAUG(t, ka0_, ka1_, qa_); qkt<KB, false, true>(S0, S1, K_lds, nullptr, r32, hi, qr, nullptr, ka0_, ka1_, qa_); } while (0)
#define XSM(t, PB) do {                                                                                                                                  \
        if ((t) == 0) { const float NEG_ = -__builtin_inff(); _Pragma("unroll") for (int r = 8; r < 16; ++r) S0[r] = NEG_; _Pragma("unroll") for (int r = 0; r < 16; ++r) S1[r] = NEG_; } \
        if (!XACT(t)) { const float NEG_ = -__builtin_inff(); _Pragma("unroll") for (int r = 0; r < 16; ++r) { S0[r] = NEG_; S1[r] = NEG_; } }           \
        else if ((t) + toff == jq) { float dqc = (float)(32 * (g & 1) + r32 - 4 * hi), n2x = n2s; asm volatile("" : "+v"(dqc), "+v"(n2x));              \
            _Pragma("unroll") for (int r = 0; r < 16; ++r) { const float c_ = (float)((r & 3) + 8 * (r >> 2));                                           \
                S0[r] = fmaf(n2x, fmaxf(c_ - dqc, 0.f), S0[r]); S1[r] = fmaf(n2x, fmaxf(c_ + 32.f - dqc, 0.f), S1[r]); } }                                \
        float m_ = (t) == 0 ? -1e30f : psc[(1 - (PB)) * 64 + 32 + r32]; float mn_, al_;                                                                  \
        partialSM<true>(S0, S1, m_, mn_, al_); finishSM(S0, S1, al_, l_reg, pa0, pa1, pa2, pa3); alpha = al_;                                           \
        if (hi == 0) { psc[(PB) * 64 + r32] = al_; psc[(PB) * 64 + 32 + r32] = mn_; }                                                                   \
        *(bf16x8*)(pbuf + (PB) * 4096) = pa0; *(bf16x8*)(pbuf + (PB) * 4096 + 1024) = pa1; *(bf16x8*)(pbuf + (PB) * 4096 + 2048) = pa2; *(bf16x8*)(pbuf + (PB) * 4096 + 3072) = pa3; } while (0)
#define XPV(t, PB, VB, OWN) do {                                                                                                                          \
        if (!(OWN)) { alpha = psc[(PB) * 64 + r32]; l_reg *= alpha;                                                                                      \
            pa0 = *(const bf16x8*)(pbuf + (PB) * 4096); pa1 = *(const bf16x8*)(pbuf + (PB) * 4096 + 1024); pa2 = *(const bf16x8*)(pbuf + (PB) * 4096 + 2048); pa3 = *(const bf16x8*)(pbuf + (PB) * 4096 + 3072); } \
        if (__any(alpha < 1.f)) { asm volatile("s_waitcnt lgkmcnt(0)" ::: "memory");                                                                      \
            for (int d_ = 0; d_ < 4; ++d_) for (int r = 0; r < 16; ++r) o[d_][r] *= psc[(PB) * 64 + crow(r, hi)]; }                                      \
        if (XACT(t)) pv_tile<VB>(o, vb0, pa0, pa1, pa2, pa3); } while (0)
    f32x16 S0, S1; bf16x8 pa0, pa1, pa2, pa3; float alpha = 1.f;
    { XLOAD_K(1); const bf16x8 n0_ = st_k0, n1_ = st_k1;
      XLOAD_K(0); XLOAD_V(0); XVMW(); XWRITE_K(0); XWRITE_V(0);
      *(bf16x8*)(K_lds + SHM_K + kws) = n0_; *(bf16x8*)(K_lds + SHM_K + kws + 32 * 256) = n1_; }
    __syncthreads();
    if (vh == 0) XQKT(0, 0);
#define XSTEP(t, PB, KBN, VBT, LAST) do {                                                                                                                 \
        const bool own_ = (((t) & 1) == vh);                                                                                                            \
        if (!(LAST)) { if ((t) + 2 < NT) XLOAD_K((t) + 2); XLOAD_V((t) + 1); }                                                                           \
        SBAR();                                                                                                                                          \
        if (own_) { XSM(t, PB); } else if (!(LAST)) { XQKT((t) + 1, KBN); }                                                                              \
        asm volatile("s_waitcnt lgkmcnt(0)" ::: "memory"); __syncthreads();                                                                              \
        if (!(LAST)) { XVMW(); if ((t) + 2 < NT) XWRITE_K(PB); XWRITE_V(1 - (PB)); }                                                                      \
        XPV(t, PB, VBT, own_);                                                                                                                            \
        asm volatile("s_waitcnt lgkmcnt(0)" ::: "memory"); __syncthreads(); } while (0)
    int t = 0;
    for (; t + 1 < NT; t += 2) {
        XSTEP(t, 0, 1, 0, false);
        XSTEP(t + 1, 1, 0, 1, false);
    }
    XSTEP(NT - 1, 0, 1, 0, true);
    int lane2; asm volatile("v_mbcnt_lo_u32_b32 %0, -1, 0\n\tv_mbcnt_hi_u32_b32 %0, -1, %0" : "=v"(lane2));
    const int r32e = lane2 & 31, hie = lane2 >> 5;
    if (hie == 0) psc[vh * 64 + r32e] = l_reg;
    asm volatile("s_waitcnt lgkmcnt(0)" ::: "memory"); __syncthreads();
    float rli[16];
#pragma unroll
    for (int r = 0; r < 16; ++r) rli[r] = __builtin_amdgcn_rcpf(psc[crow(r, hie)] + psc[64 + crow(r, hie)]);
    store_o_tile<OP>(o, rli, lds + XOFF_K + wid * 4096, u.O + (size_t)(g * QBLK) * OP + vh * 128, r32e, hie, lane2);
    asm volatile("s_waitcnt lgkmcnt(0)" ::: "memory"); __syncthreads();
#undef XKT
#undef XV0T
#undef XV1T
#undef XVMW
#undef XLOAD_K
#undef XLOAD_V
#undef XWRITE_K
#undef XWRITE_V
#undef XACT
#undef XKAUG
#undef XQKT
#undef XSM
#undef XPV
#undef XSTEP
}
#undef KSWZ
#undef K2SWZ
#undef SBAR
}

constexpr int NWAVES = 8;
constexpr int D_MODEL = 4096, BATCH = 4, SEQ = 4096, N_META = 16;
constexpr int MR = BATCH * SEQ;
constexpr int MP = MR + 256;
constexpr int NIN = 12544;
constexpr int Q_LORA = 1536, KV_LORA = 512;
constexpr float RMS_EPS = 1e-6f, LOG2E = 1.4426950408889634f;
constexpr float LAMBDA_INIT = 0.2f;
constexpr size_t MiB = 1u << 20;
constexpr size_t WS_WIN = 0;
constexpr size_t WS_O1 = 0;
constexpr size_t WS_WUQ = 98 * MiB;
constexpr size_t WS_WUKV = 107 * MiB;
constexpr size_t WS_WOUT = 111 * MiB;
constexpr size_t WS_TAB = 143 * MiB;
constexpr size_t WS_XN = 145 * MiB;
constexpr size_t WS_QD = 275 * MiB, WS_KD = 340 * MiB, WS_VD = 405 * MiB, WS_GD = 470 * MiB;
constexpr size_t WS_CQ = 535 * MiB;
constexpr size_t WS_CKV = WS_CQ + (size_t)MP * Q_LORA * 2;
constexpr size_t WS_O2 = WS_CQ;
constexpr size_t WS_GM = 600 * MiB;
constexpr size_t WS_KR = 665 * MiB;
constexpr size_t WS_QN = 668 * MiB;
constexpr size_t WS_QR = 733 * MiB;
constexpr size_t WS_KV = 766 * MiB;
constexpr size_t WS_OB = 896 * MiB;
constexpr size_t WS_CTL = 961 * MiB, CTL_ZERO_BYTES = 16384;
constexpr size_t WS_END = 962 * MiB;
static_assert(WS_CKV + (size_t)MP * KV_LORA * 2 <= WS_GM && (size_t)NIN * 4096 * 2 <= WS_WUQ && WS_XN + (size_t)MP * 4096 * 2 <= WS_QD, "d_ws map");
constexpr int RING_BYTES = 135168, LDSCTL_OFF = RING_BYTES, MISC_OFF = LDSCTL_OFF + 320, LDS_BYTES = 147456;
static_assert(att::LDS_BYTES <= RING_BYTES && att::XLDS_BYTES <= RING_BYTES, "attention LDS");
#define LAS __attribute__((address_space(3)))
#define GAS __attribute__((address_space(1)))
#define RLX_AGENT __ATOMIC_RELAXED, __HIP_MEMORY_SCOPE_AGENT
typedef unsigned short bf16;
typedef unsigned v4u __attribute__((ext_vector_type(4)));
typedef float f32x4 __attribute__((ext_vector_type(4)));
#define LDS_WAIT() asm volatile("s_waitcnt lgkmcnt(0)" ::: "memory")
__device__ __forceinline__ unsigned f2bf(float f) { unsigned u = __builtin_bit_cast(unsigned, f); return (u + 0x7fffu + ((u >> 16) & 1u)) >> 16; }
__device__ __forceinline__ unsigned pk2(float lo, float hi) { return f2bf(lo) | (f2bf(hi) << 16); }
__device__ __forceinline__ float bflo(unsigned w) { return __builtin_bit_cast(float, w << 16); }
__device__ __forceinline__ float bfhi(unsigned w) { return __builtin_bit_cast(float, w & 0xffff0000u); }
__device__ __forceinline__ float wave_sum(float v) {
#pragma unroll
    for (int o = 1; o < 64; o <<= 1) v += __shfl_xor(v, o);
    return v;
}
__device__ __forceinline__ float silu(float x) { return x / (1.f + __expf(-x)); }

__device__ __forceinline__ int lane_id() { int l; asm volatile("v_mbcnt_lo_u32_b32 %0, -1, 0\n\tv_mbcnt_hi_u32_b32 %0, -1, %0" : "=v"(l)); return l; }
#define XB_TMO      128
#define XB_XCNT(j)  (256  + 64 * (j))
#define XB_XSUB(j)  (1280 + 64 * (j))
#define XB_XGEN(j)  (2304 + 64 * (j))
#define XB_TOP      3328
#define XB_TOPGEN   3392
#define XCD_BAR_WORDS 3456
#define XB_SPIN_CAP (1u << 18)

__device__ __forceinline__ unsigned xb_ld(unsigned* p)              { return __hip_atomic_load(p, __ATOMIC_RELAXED, __HIP_MEMORY_SCOPE_AGENT); }
__device__ __forceinline__ unsigned xb_add(unsigned* p, unsigned v) { return __hip_atomic_fetch_add(p, v, __ATOMIC_RELAXED, __HIP_MEMORY_SCOPE_AGENT); }
__device__ __forceinline__ unsigned xb_xcc_id() { return (unsigned)__builtin_amdgcn_s_getreg((3 << 11) | 20) & 0xFu; }
#define XB_SPIN(cond, bar) do { unsigned _sp = 0; while (cond) { __builtin_amdgcn_s_sleep(1); \
    if ((++_sp & 255u) == 0u) { if (xb_ld(&(bar)[XB_TMO])) break; if (_sp > XB_SPIN_CAP) { atomicAdd(&(bar)[XB_TMO], 1u); break; } } } } while (0)

struct XcdBarrier {
    unsigned* bar; unsigned x; int w;
    volatile LAS unsigned* st;
};

__device__ __forceinline__ XcdBarrier xcd_barrier_post(unsigned* bar, volatile LAS unsigned* st, int wave_) {
    XcdBarrier b; b.bar = bar; b.x = xb_xcc_id(); b.st = st; b.w = wave_;
    if (wave_ == 0 && lane_id() == 0) (void)xb_add(&bar[XB_XCNT(b.x)], 1u);
    return b;
}
__device__ __forceinline__ void xcd_barrier_complete(unsigned* bar, unsigned x, unsigned& nloc, unsigned& nx) {
    const unsigned G = gridDim.x * gridDim.y * gridDim.z;
    unsigned sum, cnt, mine, sp = 0u;
    for (;;) {
        sum = 0u; cnt = 0u; mine = 0u;
#pragma unroll
        for (unsigned j = 0; j < 16; ++j) { const unsigned c = xb_ld(&bar[XB_XCNT(j)]); sum += c; cnt += (c > 0u) ? 1u : 0u; mine = (j == x) ? c : mine; }
        if (sum == G) break;
        __builtin_amdgcn_s_sleep(1);
        if ((++sp & 255u) == 0u) { if (xb_ld(&bar[XB_TMO])) break; if (sp > XB_SPIN_CAP) { atomicAdd(&bar[XB_TMO], 1u); break; } }
    }
    nloc = mine > 0u ? mine : 1u; nx = cnt > 0u ? cnt : 1u;
}

__device__ __forceinline__ void xcd_barrier(const XcdBarrier& b) {
    asm volatile("s_waitcnt vmcnt(0)" ::: "memory");
    __syncthreads();
    if (b.w == 0 && lane_id() == 0) {
        unsigned* bar = b.bar;
        __builtin_amdgcn_s_waitcnt(0);
        unsigned nloc = b.st[0], nx = b.st[1];
        if (nloc == 0u) { xcd_barrier_complete(bar, b.x, nloc, nx); b.st[0] = nloc; b.st[1] = nx; }
        const unsigned old = xb_add(&bar[XB_XSUB(b.x)], 1u);
        const unsigned gen = old / nloc;
        if (old + 1u == (gen + 1u) * nloc) {
            __builtin_amdgcn_fence(__ATOMIC_RELEASE, "agent");
            asm volatile("s_waitcnt vmcnt(0)" ::: "memory");
            const unsigned og = xb_add(&bar[XB_TOP], 1u);
            const unsigned tg = og / nx;
            if (og + 1u == (tg + 1u) * nx) xb_add(&bar[XB_TOPGEN], 1u);
            else XB_SPIN(xb_ld(&bar[XB_TOPGEN]) == tg, bar);
            __builtin_amdgcn_fence(__ATOMIC_ACQUIRE, "agent");
            xb_add(&bar[XB_XGEN(b.x)], 1u);
            asm volatile("s_waitcnt vmcnt(0)" ::: "memory");
        } else {
            XB_SPIN(xb_ld(&bar[XB_XGEN(b.x)]) == gen, bar);
            __builtin_amdgcn_fence(__ATOMIC_ACQUIRE, "agent");
            asm volatile("s_waitcnt vmcnt(0)" ::: "memory");
        }
    }
    __syncthreads();
}

struct MapIn { __device__ __forceinline__ int operator()(int n) const {
    if (n < 10240) return n; if (n < 12288) return n + 64; if (n < 12352) { const int j = n - 12288; return 10240 + (j & 1) * 32 + (j >> 1); } return -1; } };
struct MapUq { __device__ __forceinline__ int operator()(int n) const {
    if (n < 2048) return (n >> 7) * 192 + (n & 127); const int j = n - 2048, h = j >> 6, jj = j & 63; return h * 192 + 128 + (jj & 1) * 32 + (jj >> 1); } };
struct MapId { __device__ __forceinline__ int operator()(int n) const { return n; } };
struct MapInB { __device__ __forceinline__ int operator()(int n) const { return MapIn{}(n + 12288); } };
struct MapUqB { __device__ __forceinline__ int operator()(int n) const { return MapUq{}(n + 2048); } };
template <bool GATHER, class Map>
__device__ __forceinline__ void p0_transpose_item(const float* W, int K, int Nsrc, int Nd, bf16* WT, LAS float* scr, int item, int lane, Map map) {
    const int nblk = Nd / 64, kb = item / nblk, nb = item % nblk, k0 = 64 * kb, n0 = 64 * nb;
    const int nq = 4 * (lane & 15), kr = lane >> 4;
    f32x4 v[16];
    if constexpr (GATHER) {
        const int s0 = map(n0 + nq), s1 = map(n0 + nq + 1), s2 = map(n0 + nq + 2), s3 = map(n0 + nq + 3);
#pragma unroll
        for (int i = 0; i < 16; ++i) { const float* r = W + (size_t)(k0 + 4 * i + kr) * Nsrc; v[i] = (f32x4){s0 >= 0 ? r[s0] : 0.f, s1 >= 0 ? r[s1] : 0.f, s2 >= 0 ? r[s2] : 0.f, s3 >= 0 ? r[s3] : 0.f}; }
    } else {
        const int s0 = map(n0 + nq);
#pragma unroll
        for (int i = 0; i < 16; ++i) v[i] = s0 >= 0 ? __builtin_nontemporal_load((const f32x4*)(W + (size_t)(k0 + 4 * i + kr) * Nsrc + s0)) : (f32x4){0.f, 0.f, 0.f, 0.f};
    }
#pragma unroll
    for (int i = 0; i < 16; ++i) { LAS float* d = scr + (4 * i + kr) * 65 + nq; d[0] = v[i][0]; d[1] = v[i][1]; d[2] = v[i][2]; d[3] = v[i][3]; }
    LDS_WAIT(); asm volatile("" ::: "memory");
    const int c = lane & 7;
#pragma unroll
    for (int j = 0; j < 8; ++j) { const int n = (lane >> 3) + 8 * j; const LAS float* s = scr + (8 * c) * 65 + n;
        v4u o; o.x = pk2(s[0 * 65], s[1 * 65]); o.y = pk2(s[2 * 65], s[3 * 65]); o.z = pk2(s[4 * 65], s[5 * 65]); o.w = pk2(s[6 * 65], s[7 * 65]);
        *(v4u*)(WT + (size_t)(n0 + n) * K + k0 + 8 * c) = o; }
    LDS_WAIT(); asm volatile("" ::: "memory");
}
__device__ __forceinline__ void rms_row_to_bf16(const float* xrow, const float* g, bf16* orow, int lane) {
    const f32x4* xr = (const f32x4*)xrow + lane; const f32x4* gr = (const f32x4*)g + lane;
    f32x4 v[16]; float s = 0.f;
#pragma unroll
    for (int j = 0; j < 16; ++j) { v[j] = __builtin_nontemporal_load(xr + 64 * j); s += (v[j].x * v[j].x + v[j].y * v[j].y) + (v[j].z * v[j].z + v[j].w * v[j].w); }
    const float rstd = 1.f / sqrtf(wave_sum(s) * (1.f / D_MODEL) + RMS_EPS);
    unsigned long long* o8 = (unsigned long long*)orow + lane;
#pragma unroll
    for (int j = 0; j < 16; ++j) { const f32x4 gg = gr[64 * j];
        o8[64 * j] = (unsigned long long)pk2(v[j].x * rstd * gg.x, v[j].y * rstd * gg.y) | ((unsigned long long)pk2(v[j].z * rstd * gg.z, v[j].w * rstd * gg.w) << 32); }
}

typedef short bf16x8 __attribute__((ext_vector_type(8)));
template <int RB, int NB>
__device__ __forceinline__ void mini_gemm(const bf16* A, size_t lda, const bf16* Bt, size_t ldb, int K, f32x4 (&acc)[RB][NB], int lane) {
    const bf16* ap = A + (size_t)(lane & 15) * lda + 8 * (lane >> 4); const bf16* bp = Bt + (size_t)(lane & 15) * ldb + 8 * (lane >> 4);
#pragma unroll
    for (int rb = 0; rb < RB; ++rb)
#pragma unroll
        for (int nb = 0; nb < NB; ++nb) acc[rb][nb] = (f32x4){0.f, 0.f, 0.f, 0.f};
#pragma unroll 4
    for (int k0 = 0; k0 < K; k0 += 32) { bf16x8 a[RB], b[NB];
#pragma unroll
        for (int rb = 0; rb < RB; ++rb) a[rb] = *(const bf16x8*)(ap + (size_t)rb * 16 * lda + k0);
#pragma unroll
        for (int nb = 0; nb < NB; ++nb) b[nb] = *(const bf16x8*)(bp + (size_t)nb * 16 * ldb + k0);
#pragma unroll
        for (int rb = 0; rb < RB; ++rb)
#pragma unroll
            for (int nb = 0; nb < NB; ++nb) acc[rb][nb] = __builtin_amdgcn_mfma_f32_16x16x32_bf16(a[rb], b[nb], acc[rb][nb], 0, 0, 0); }
}
template <int RB, int NB>
__device__ __forceinline__ void wg_task(const bf16* A, const bf16* Bt, LAS float* red, f32x4 (&res)[RB * NB / 4], int wave, int lane) {
    f32x4 acc[RB][NB]; mini_gemm<RB, NB>(A + 512 * wave, 4096, Bt + 512 * wave, 4096, 512, acc, lane);
#pragma unroll
    for (int r = 0; r < RB * NB / 4; ++r) {
#pragma unroll
        for (int i = 0; i < 4; ++i) *(LAS f32x4*)(red + ((wave * 4 + i) * 64 + lane) * 4) = acc[(4 * r + i) / NB][(4 * r + i) % NB];
        __syncthreads();
        f32x4 s = {0.f, 0.f, 0.f, 0.f};
        if (wave < 4) {
#pragma unroll
            for (int w = 0; w < 8; ++w) s += *(LAS f32x4*)(red + ((w * 4 + wave) * 64 + lane) * 4); }
        res[r] = s;
        __syncthreads(); }
}

__device__ const unsigned short ATT_ORDER[3072] = {
    32783,32799,32815,32831,32847,32863,32879,32895,32911,32927,32943,32959,32975,32991,33007,33023,33039,33055,33071,33087,33103,33119,33135,33151,33167,33183,33199,33215,33231,33247,33263,33279,
    33295,33311,33327,33343,33359,33375,33391,33407,33423,33439,33455,33471,33487,33503,33519,33535,33551,33567,33583,33599,33615,33631,33647,33663,33679,33695,33711,33727,33743,33759,33775,33791,
    32782,32798,32814,32830,32846,32862,32878,32894,32910,32926,32942,32958,32974,32990,33006,33022,33038,33054,33070,33086,33102,33118,33134,33150,33166,33182,33198,33214,33230,33246,33262,33278,
    33294,33310,33326,33342,33358,33374,33390,33406,33422,33438,33454,33470,33486,33502,33518,33534,33550,33566,33582,33598,33614,33630,33646,33662,33678,33694,33710,33726,33742,33758,33774,33790,
    32781,32797,32813,32829,32845,32861,32877,32893,32909,32925,32941,32957,32973,32989,33005,33021,33037,33053,33069,33085,33101,33117,33133,33149,33165,33181,33197,33213,33229,33245,33261,33277,
    33293,33309,33325,33341,33357,33373,33389,33405,33421,33437,33453,33469,33485,33501,33517,33533,33549,33565,33581,33597,33613,33629,33645,33661,33677,33693,33709,33725,33741,33757,33773,33789,
    32780,32796,32812,32828,32844,32860,32876,32892,32908,32924,32940,32956,32972,32988,33004,33020,33036,33052,33068,33084,33100,33116,33132,33148,33164,33180,33196,33212,33228,33244,33260,33276,
    33292,33308,33324,33340,33356,33372,33388,33404,33420,33436,33452,33468,33484,33500,33516,33532,33548,33564,33580,33596,33612,33628,33644,33660,33676,33692,33708,33724,33740,33756,33772,33788,
    32779,32795,32811,32827,32843,32859,32875,32891,32907,32923,32939,32955,32971,32987,33003,33019,33035,33051,33067,33083,33099,33115,33131,33147,33163,33179,33195,33211,33227,33243,33259,33275,
    33291,33307,33323,33339,33355,33371,33387,33403,33419,33435,33451,33467,33483,33499,33515,33531,33547,33563,33579,33595,33611,33627,33643,33659,33675,33691,33707,33723,33739,33755,33771,33787,
    32778,32794,32810,32826,32842,32858,32874,32890,32906,32922,32938,32954,32970,32986,33002,33018,33034,33050,33066,33082,33098,33114,33130,33146,33162,33178,33194,33210,33226,33242,33258,33274,
    33290,33306,33322,33338,33354,33370,33386,33402,33418,33434,33450,33466,33482,33498,33514,33530,33546,33562,33578,33594,33610,33626,33642,33658,33674,33690,33706,33722,33738,33754,33770,33786,
    32777,32793,32809,32825,32841,32857,32873,32889,32905,32921,32937,32953,32969,32985,33001,33017,33033,33049,33065,33081,33097,33113,33129,33145,33161,33177,33193,33209,33225,33241,33257,33273,
    33289,33305,33321,33337,33353,33369,33385,33401,33417,33433,33449,33465,33481,33497,33513,33529,33545,33561,33577,33593,33609,33625,33641,33657,33673,33689,33705,33721,33737,33753,33769,33785,
    287,319,351,383,415,447,479,511,799,831,863,895,927,959,991,1023,1311,1343,1375,1407,1439,1471,1503,1535,1823,1855,1887,1919,1951,1983,2015,2047,
    286,318,350,382,414,446,478,510,798,830,862,894,926,958,990,1022,1310,1342,1374,1406,1438,1470,1502,1534,1822,1854,1886,1918,1950,1982,2014,2046,
    285,317,349,381,413,445,477,509,797,829,861,893,925,957,989,1021,1309,1341,1373,1405,1437,1469,1501,1533,1821,1853,1885,1917,1949,1981,2013,2045,
    32776,32792,32808,32824,32840,32856,32872,32888,32904,32920,32936,32952,32968,32984,33000,33016,33032,33048,33064,33080,33096,33112,33128,33144,33160,33176,33192,33208,33224,33240,33256,33272,
    33288,33304,33320,33336,33352,33368,33384,33400,33416,33432,33448,33464,33480,33496,33512,33528,33544,33560,33576,33592,33608,33624,33640,33656,33672,33688,33704,33720,33736,33752,33768,33784,
    284,316,348,380,412,444,476,508,796,828,860,892,924,956,988,1020,1308,1340,1372,1404,1436,1468,1500,1532,1820,1852,1884,1916,1948,1980,2012,2044,
    283,315,347,379,411,443,475,507,795,827,859,891,923,955,987,1019,1307,1339,1371,1403,1435,1467,1499,1531,1819,1851,1883,1915,1947,1979,2011,2043,
    282,314,346,378,410,442,474,506,794,826,858,890,922,954,986,1018,1306,1338,1370,1402,1434,1466,1498,1530,1818,1850,1882,1914,1946,1978,2010,2042,
    32775,32791,32807,32823,32839,32855,32871,32887,32903,32919,32935,32951,32967,32983,32999,33015,33031,33047,33063,33079,33095,33111,33127,33143,33159,33175,33191,33207,33223,33239,33255,33271,
    33287,33303,33319,33335,33351,33367,33383,33399,33415,33431,33447,33463,33479,33495,33511,33527,33543,33559,33575,33591,33607,33623,33639,33655,33671,33687,33703,33719,33735,33751,33767,33783,
    281,313,345,377,409,441,473,505,793,825,857,889,921,953,985,1017,1305,1337,1369,1401,1433,1465,1497,1529,1817,1849,1881,1913,1945,1977,2009,2041,
    280,312,344,376,408,440,472,504,792,824,856,888,920,952,984,1016,1304,1336,1368,1400,1432,1464,1496,1528,1816,1848,1880,1912,1944,1976,2008,2040,
    279,311,343,375,407,439,471,503,791,823,855,887,919,951,983,1015,1303,1335,1367,1399,1431,1463,1495,1527,1815,1847,1879,1911,1943,1975,2007,2039,
    278,310,342,374,406,438,470,502,790,822,854,886,918,950,982,1014,1302,1334,1366,1398,1430,1462,1494,1526,1814,1846,1878,1910,1942,1974,2006,2038,
    32774,32790,32806,32822,32838,32854,32870,32886,32902,32918,32934,32950,32966,32982,32998,33014,33030,33046,33062,33078,33094,33110,33126,33142,33158,33174,33190,33206,33222,33238,33254,33270,
    33286,33302,33318,33334,33350,33366,33382,33398,33414,33430,33446,33462,33478,33494,33510,33526,33542,33558,33574,33590,33606,33622,33638,33654,33670,33686,33702,33718,33734,33750,33766,33782,
    277,309,341,373,405,437,469,501,789,821,853,885,917,949,981,1013,1301,1333,1365,1397,1429,1461,1493,1525,1813,1845,1877,1909,1941,1973,2005,2037,
    276,308,340,372,404,436,468,500,788,820,852,884,916,948,980,1012,1300,1332,1364,1396,1428,1460,1492,1524,1812,1844,1876,1908,1940,1972,2004,2036,
    275,307,339,371,403,435,467,499,787,819,851,883,915,947,979,1011,1299,1331,1363,1395,1427,1459,1491,1523,1811,1843,1875,1907,1939,1971,2003,2035,
    32773,32789,32805,32821,32837,32853,32869,32885,32901,32917,32933,32949,32965,32981,32997,33013,33029,33045,33061,33077,33093,33109,33125,33141,33157,33173,33189,33205,33221,33237,33253,33269,
    33285,33301,33317,33333,33349,33365,33381,33397,33413,33429,33445,33461,33477,33493,33509,33525,33541,33557,33573,33589,33605,33621,33637,33653,33669,33685,33701,33717,33733,33749,33765,33781,
    274,306,338,370,402,434,466,498,786,818,850,882,914,946,978,1010,1298,1330,1362,1394,1426,1458,1490,1522,1810,1842,1874,1906,1938,1970,2002,2034,
    273,305,337,369,401,433,465,497,785,817,849,881,913,945,977,1009,1297,1329,1361,1393,1425,1457,1489,1521,1809,1841,1873,1905,1937,1969,2001,2033,
    208,209,210,211,212,213,214,215,216,217,218,219,220,221,222,223,240,241,242,243,244,245,246,247,248,249,250,251,252,253,254,255,
    272,304,336,368,400,432,464,496,720,721,722,723,724,725,726,727,728,729,730,731,732,733,734,735,752,753,754,755,756,757,758,759,
    760,761,762,763,764,765,766,767,784,816,848,880,912,944,976,1008,1232,1233,1234,1235,1236,1237,1238,1239,1240,1241,1242,1243,1244,1245,1246,1247,
    1264,1265,1266,1267,1268,1269,1270,1271,1272,1273,1274,1275,1276,1277,1278,1279,1296,1328,1360,1392,1424,1456,1488,1520,1744,1745,1746,1747,1748,1749,1750,1751,
    1752,1753,1754,1755,1756,1757,1758,1759,1776,1777,1778,1779,1780,1781,1782,1783,1784,1785,1786,1787,1788,1789,1790,1791,1808,1840,1872,1904,1936,1968,2000,2032,
    32772,32788,32804,32820,32836,32852,32868,32884,32900,32916,32932,32948,32964,32980,32996,33012,33028,33044,33060,33076,33092,33108,33124,33140,33156,33172,33188,33204,33220,33236,33252,33268,
    33284,33300,33316,33332,33348,33364,33380,33396,33412,33428,33444,33460,33476,33492,33508,33524,33540,33556,33572,33588,33604,33620,33636,33652,33668,33684,33700,33716,33732,33748,33764,33780,
    207,239,271,303,335,367,399,431,463,495,719,751,783,815,847,879,911,943,975,1007,1231,1263,1295,1327,1359,1391,1423,1455,1487,1519,1743,1775,
    1807,1839,1871,1903,1935,1967,1999,2031,206,238,270,302,334,366,398,430,462,494,718,750,782,814,846,878,910,942,974,1006,1230,1262,1294,1326,
    1358,1390,1422,1454,1486,1518,1742,1774,1806,1838,1870,1902,1934,1966,1998,2030,205,237,269,301,333,365,397,429,461,493,717,749,781,813,845,877,
    909,941,973,1005,1229,1261,1293,1325,1357,1389,1421,1453,1485,1517,1741,1773,1805,1837,1869,1901,1933,1965,1997,2029,32771,32787,32803,32819,32835,32851,32867,32883,
    32899,32915,32931,32947,32963,32979,32995,33011,33027,33043,33059,33075,33091,33107,33123,33139,33155,33171,33187,33203,33219,33235,33251,33267,33283,33299,33315,33331,33347,33363,33379,33395,
    33411,33427,33443,33459,33475,33491,33507,33523,33539,33555,33571,33587,33603,33619,33635,33651,33667,33683,33699,33715,33731,33747,33763,33779,204,236,268,300,332,364,396,428,
    460,492,716,748,780,812,844,876,908,940,972,1004,1228,1260,1292,1324,1356,1388,1420,1452,1484,1516,1740,1772,1804,1836,1868,1900,1932,1964,1996,2028,
    203,235,267,299,331,363,395,427,459,491,715,747,779,811,843,875,907,939,971,1003,1227,1259,1291,1323,1355,1387,1419,1451,1483,1515,1739,1771,
    1803,1835,1867,1899,1931,1963,1995,2027,202,234,266,298,330,362,394,426,458,490,714,746,778,810,842,874,906,938,970,1002,1226,1258,1290,1322,
    1354,1386,1418,1450,1482,1514,1738,1770,1802,1834,1866,1898,1930,1962,1994,2026,201,233,265,297,329,361,393,425,457,489,713,745,777,809,841,873,
    905,937,969,1001,1225,1257,1289,1321,1353,1385,1417,1449,1481,1513,1737,1769,1801,1833,1865,1897,1929,1961,1993,2025,32770,32786,32802,32818,32834,32850,32866,32882,
    32898,32914,32930,32946,32962,32978,32994,33010,33026,33042,33058,33074,33090,33106,33122,33138,33154,33170,33186,33202,33218,33234,33250,33266,33282,33298,33314,33330,33346,33362,33378,33394,
    33410,33426,33442,33458,33474,33490,33506,33522,33538,33554,33570,33586,33602,33618,33634,33650,33666,33682,33698,33714,33730,33746,33762,33778,136,137,138,139,140,141,142,143,
    144,145,146,147,148,149,150,151,152,153,154,155,156,157,158,159,168,169,170,171,172,173,174,175,176,177,178,179,180,181,182,183,
    184,185,186,187,188,189,190,191,200,232,264,296,328,360,392,424,456,488,648,649,650,651,652,653,654,655,656,657,658,659,660,661,
    662,663,664,665,666,667,668,669,670,671,680,681,682,683,684,685,686,687,688,689,690,691,692,693,694,695,696,697,698,699,700,701,
    702,703,712,744,776,808,840,872,904,936,968,1000,1160,1161,1162,1163,1164,1165,1166,1167,1168,1169,1170,1171,1172,1173,1174,1175,1176,1177,1178,1179,
    1180,1181,1182,1183,1192,1193,1194,1195,1196,1197,1198,1199,1200,1201,1202,1203,1204,1205,1206,1207,1208,1209,1210,1211,1212,1213,1214,1215,1224,1256,1288,1320,
    1352,1384,1416,1448,1480,1512,1672,1673,1674,1675,1676,1677,1678,1679,1680,1681,1682,1683,1684,1685,1686,1687,1688,1689,1690,1691,1692,1693,1694,1695,1704,1705,
    1706,1707,1708,1709,1710,1711,1712,1713,1714,1715,1716,1717,1718,1719,1720,1721,1722,1723,1724,1725,1726,1727,1736,1768,1800,1832,1864,1896,1928,1960,1992,2024,
    135,167,199,231,263,295,327,359,391,423,455,487,647,679,711,743,775,807,839,871,903,935,967,999,1159,1191,1223,1255,1287,1319,1351,1383,
    1415,1447,1479,1511,1671,1703,1735,1767,1799,1831,1863,1895,1927,1959,1991,2023,134,166,198,230,262,294,326,358,390,422,454,486,646,678,710,742,
    774,806,838,870,902,934,966,998,1158,1190,1222,1254,1286,1318,1350,1382,1414,1446,1478,1510,1670,1702,1734,1766,1798,1830,1862,1894,1926,1958,1990,2022,
    32769,32785,32801,32817,32833,32849,32865,32881,32897,32913,32929,32945,32961,32977,32993,33009,33025,33041,33057,33073,33089,33105,33121,33137,33153,33169,33185,33201,33217,33233,33249,33265,
    33281,33297,33313,33329,33345,33361,33377,33393,33409,33425,33441,33457,33473,33489,33505,33521,33537,33553,33569,33585,33601,33617,33633,33649,33665,33681,33697,33713,33729,33745,33761,33777,
    133,165,197,229,261,293,325,357,389,421,453,485,645,677,709,741,773,805,837,869,901,933,965,997,1157,1189,1221,1253,1285,1317,1349,1381,
    1413,1445,1477,1509,1669,1701,1733,1765,1797,1829,1861,1893,1925,1957,1989,2021,68,69,70,71,72,73,74,75,76,77,78,79,80,81,82,83,
    84,85,86,87,88,89,90,91,92,93,94,95,100,101,102,103,104,105,106,107,108,109,110,111,112,113,114,115,116,117,118,119,
    120,121,122,123,124,125,126,127,132,164,196,228,260,292,324,356,388,420,452,484,580,581,582,583,584,585,586,587,588,589,590,591,
    592,593,594,595,596,597,598,599,600,601,602,603,604,605,606,607,612,613,614,615,616,617,618,619,620,621,622,623,624,625,626,627,
    628,629,630,631,632,633,634,635,636,637,638,639,644,676,708,740,772,804,836,868,900,932,964,996,1092,1093,1094,1095,1096,1097,1098,1099,
    1100,1101,1102,1103,1104,1105,1106,1107,1108,1109,1110,1111,1112,1113,1114,1115,1116,1117,1118,1119,1124,1125,1126,1127,1128,1129,1130,1131,1132,1133,1134,1135,
    1136,1137,1138,1139,1140,1141,1142,1143,1144,1145,1146,1147,1148,1149,1150,1151,1156,1188,1220,1252,1284,1316,1348,1380,1412,1444,1476,1508,1604,1605,1606,1607,
    1608,1609,1610,1611,1612,1613,1614,1615,1616,1617,1618,1619,1620,1621,1622,1623,1624,1625,1626,1627,1628,1629,1630,1631,1636,1637,1638,1639,1640,1641,1642,1643,
    1644,1645,1646,1647,1648,1649,1650,1651,1652,1653,1654,1655,1656,1657,1658,1659,1660,1661,1662,1663,1668,1700,1732,1764,1796,1828,1860,1892,1924,1956,1988,2020,
    67,99,131,163,195,227,259,291,323,355,387,419,451,483,579,611,643,675,707,739,771,803,835,867,899,931,963,995,1091,1123,1155,1187,
    1219,1251,1283,1315,1347,1379,1411,1443,1475,1507,1603,1635,1667,1699,1731,1763,1795,1827,1859,1891,1923,1955,1987,2019,32768,32784,32800,32816,32832,32848,32864,32880,
    32896,32912,32928,32944,32960,32976,32992,33008,33024,33040,33056,33072,33088,33104,33120,33136,33152,33168,33184,33200,33216,33232,33248,33264,33280,33296,33312,33328,33344,33360,33376,33392,
    33408,33424,33440,33456,33472,33488,33504,33520,33536,33552,33568,33584,33600,33616,33632,33648,33664,33680,33696,33712,33728,33744,33760,33776,2,3,4,5,6,7,8,9,
    10,11,12,13,14,15,16,17,18,19,20,21,22,23,24,25,26,27,28,29,30,31,34,35,36,37,38,39,40,41,42,43,
    44,45,46,47,48,49,50,51,52,53,54,55,56,57,58,59,60,61,62,63,66,98,130,162,194,226,258,290,322,354,386,418,
    450,482,514,515,516,517,518,519,520,521,522,523,524,525,526,527,528,529,530,531,532,533,534,535,536,537,538,539,540,541,542,543,
    546,547,548,549,550,551,552,553,554,555,556,557,558,559,560,561,562,563,564,565,566,567,568,569,570,571,572,573,574,575,578,610,
    642,674,706,738,770,802,834,866,898,930,962,994,1026,1027,1028,1029,1030,1031,1032,1033,1034,1035,1036,1037,1038,1039,1040,1041,1042,1043,1044,1045,
    1046,1047,1048,1049,1050,1051,1052,1053,1054,1055,1058,1059,1060,1061,1062,1063,1064,1065,1066,1067,1068,1069,1070,1071,1072,1073,1074,1075,1076,1077,1078,1079,
    1080,1081,1082,1083,1084,1085,1086,1087,1090,1122,1154,1186,1218,1250,1282,1314,1346,1378,1410,1442,1474,1506,1538,1539,1540,1541,1542,1543,1544,1545,1546,1547,
    1548,1549,1550,1551,1552,1553,1554,1555,1556,1557,1558,1559,1560,1561,1562,1563,1564,1565,1566,1567,1570,1571,1572,1573,1574,1575,1576,1577,1578,1579,1580,1581,
    1582,1583,1584,1585,1586,1587,1588,1589,1590,1591,1592,1593,1594,1595,1596,1597,1598,1599,1602,1634,1666,1698,1730,1762,1794,1826,1858,1890,1922,1954,1986,2018,
    1,33,65,97,129,161,193,225,257,289,321,353,385,417,449,481,513,545,577,609,641,673,705,737,769,801,833,865,897,929,961,993,
    1025,1057,1089,1121,1153,1185,1217,1249,1281,1313,1345,1377,1409,1441,1473,1505,1537,1569,1601,1633,1665,1697,1729,1761,1793,1825,1857,1889,1921,1953,1985,2017,
    0,32,64,96,128,160,192,224,256,288,320,352,384,416,448,480,512,544,576,608,640,672,704,736,768,800,832,864,896,928,960,992,
    1024,1056,1088,1120,1152,1184,1216,1248,1280,1312,1344,1376,1408,1440,1472,1504,1536,1568,1600,1632,1664,1696,1728,1760,1792,1824,1856,1888,1920,1952,1984,2016,
};

struct Args { const float* in[15]; float* out; unsigned char* ws; int ph_lo, ph_hi; };
__global__ void __launch_bounds__(NWAVES * 64, 2) hybrid_fwd(Args args) {
    extern __shared__ __attribute__((aligned(16))) unsigned char lds[];
    cg::grid_group grid = cg::this_grid();
    const int wave = __builtin_amdgcn_readfirstlane((int)threadIdx.x >> 6);
#define lane lane_id()
#define tid (wave * 64 + lane_id())
    const int G = gridDim.x, bx = blockIdx.x, vcu = (G % 8 == 0) ? (bx % 8) * (G / 8) + bx / 8 : bx;
    const int gw = vcu * NWAVES + wave, NGW = G * NWAVES;
    unsigned char* ws = args.ws;
    const float* x = args.in[0]; const float* meta = args.in[1]; const float* g_pre = args.in[2]; const float* w_in = args.in[3];
    const float* lq1 = args.in[4]; const float* lk1 = args.in[5]; const float* lq2 = args.in[6]; const float* lk2 = args.in[7];
    const float* subln = args.in[8]; const float* g_cq = args.in[9]; const float* g_ckv = args.in[10];
    const float* w_uq = args.in[11]; const float* w_ukv = args.in[12]; const float* w_out = args.in[13]; const float* g_post = args.in[14];
    float* out = args.out;
    bf16* Wt_in = (bf16*)(ws + WS_WIN); bf16* Wt_uq = (bf16*)(ws + WS_WUQ); bf16* Wt_ukv = (bf16*)(ws + WS_WUKV); bf16* Wt_out = (bf16*)(ws + WS_WOUT);
    float* cosT = (float*)(ws + WS_TAB); float* sinT = cosT + 4112 * 32;
    float* KN2 = (float*)(ws + WS_TAB + 1536 * 1024); float* QST = KN2 + 16 * 4 * 65; float* CKVM = QST + 16 * 4 * 128;
    bf16* XN = (bf16*)(ws + WS_XN); bf16* MIX = XN;
    bf16* QD = (bf16*)(ws + WS_QD); bf16* KD = (bf16*)(ws + WS_KD); bf16* VD = (bf16*)(ws + WS_VD); bf16* GD = (bf16*)(ws + WS_GD);
    bf16* CQ = (bf16*)(ws + WS_CQ); bf16* CKV = (bf16*)(ws + WS_CKV); bf16* GM = (bf16*)(ws + WS_GM); bf16* KR = (bf16*)(ws + WS_KR);
    bf16* QN = (bf16*)(ws + WS_QN); bf16* QR = (bf16*)(ws + WS_QR); bf16* KV = (bf16*)(ws + WS_KV);
    bf16* Y16 = (bf16*)(ws + WS_QD);     bf16* O1 = (bf16*)(ws + WS_O1); bf16* O2 = (bf16*)(ws + WS_O2); bf16* OB = (bf16*)(ws + WS_OB);
    const int lo = args.ph_lo, hi_ph = args.ph_hi;
    for (int w_ = tid; w_ < (LDS_BYTES - LDSCTL_OFF) / 4; w_ += NWAVES * 64) ((LAS unsigned*)((LAS unsigned char*)lds + LDSCTL_OFF))[w_] = 0u;
    __syncthreads();
    XcdBarrier bar = xcd_barrier_post((unsigned*)(ws + WS_CTL), (volatile LAS unsigned*)((LAS unsigned char*)lds + MISC_OFF) + 8, wave);
    if (lo == 0x7fffffff) grid.sync();
#ifndef PH_MASK
#define PH_MASK 0xff
#endif
#define IN(k) (((PH_MASK >> (k)) & 1) && lo <= (k) && (k) < hi_ph)
#ifndef REP_MASK
#define REP_MASK 0
#endif
#define REP(k) (((REP_MASK >> (k)) & 1) ? 2 : 1)
#define SEAM(k) do { if (lo <= (k) && (k) + 1 < hi_ph) xcd_barrier(bar); } while (0)

    if (IN(0)) for (int rep_ = 0; rep_ < REP(0); ++rep_) {
        LAS float* scr = (LAS float*)((LAS unsigned char*)lds + wave * 16640);
        constexpr int I_INA = (4096 / 64) * (12288 / 64), I_INB = (4096 / 64) * (256 / 64), I_UQA = (Q_LORA / 64) * (2048 / 64), I_UQB = (Q_LORA / 64) * (1024 / 64), I_UKV = (KV_LORA / 64) * (4096 / 64), I_OUT = (4096 / 64) * (4096 / 64);
        constexpr int NITEMS = I_INA + I_INB + I_UQA + I_UQB + I_UKV + I_OUT;
        for (int it = gw; it < NITEMS; it += NGW) {
            int r = it;
            if (r < I_INA) { p0_transpose_item<false>(w_in, 4096, 12352, 12288, Wt_in, scr, r, lane, MapIn{}); continue; } r -= I_INA;
            if (r < I_INB) { p0_transpose_item<true>(w_in, 4096, 12352, 256, Wt_in + (size_t)12288 * 4096, scr, r, lane, MapInB{}); continue; } r -= I_INB;
            if (r < I_UQA) { p0_transpose_item<false>(w_uq, Q_LORA, 3072, 2048, Wt_uq, scr, r, lane, MapUq{}); continue; } r -= I_UQA;
            if (r < I_UQB) { p0_transpose_item<true>(w_uq, Q_LORA, 3072, 1024, Wt_uq + (size_t)2048 * Q_LORA, scr, r, lane, MapUqB{}); continue; } r -= I_UQB;
            if (r < I_UKV) { p0_transpose_item<false>(w_ukv, KV_LORA, 4096, 4096, Wt_ukv, scr, r, lane, MapId{}); continue; } r -= I_UKV;
            p0_transpose_item<false>(w_out, 4096, 4096, 4096, Wt_out, scr, r, lane, MapId{});
        }
        for (int m = gw; m < MP; m += NGW) {
            if (m < MR) rms_row_to_bf16(x + (size_t)m * D_MODEL, g_pre, XN + (size_t)m * D_MODEL, lane);
            else { const int mm = (m - MR) & 63;
                if (mm < N_META) rms_row_to_bf16(meta + (size_t)mm * D_MODEL, g_pre, XN + (size_t)m * D_MODEL, lane);
                else { v4u z = {0u, 0u, 0u, 0u}; v4u* o = (v4u*)(XN + (size_t)m * D_MODEL) + lane;
#pragma unroll
                    for (int j = 0; j < 8; ++j) o[64 * j] = z; } }
        }
        for (int blk = gw; blk < 256; blk += NGW) { const int tns = blk >> 6, hb = blk & 63;
            bf16* base = (tns == 0 ? KD : tns == 1 ? VD : KV + (size_t)(tns - 2) * 16 * MP * 128) + ((size_t)(hb >> 2) * MP + MR + 64 * (hb & 3) + 16) * 128;
            const v4u z = {0u, 0u, 0u, 0u};
#pragma unroll
            for (int j = 0; j < 12; ++j) ((v4u*)base)[64 * j + lane] = z; }
        for (int e = gw * 64 + lane; e < 4112 * 32; e += NGW * 64) { const int pos = e >> 5, i = e & 31;
            const float inv_freq = exp2f(-(float)(2 * i) * (13.287712379549449f / 64.f));
            const double rev = (double)pos * (double)inv_freq * 0.15915494309189535; const float fr = (float)(rev - floor(rev));
            cosT[e] = __builtin_amdgcn_cosf(fr); sinT[e] = __builtin_amdgcn_sinf(fr); }
    }
    SEAM(0);
    if (IN(1)) for (int rep_ = 0; rep_ < (REP(1) == 2 ? hi_ph - 6 : 1); ++rep_) {
        pg8::Gemm g{XN, Wt_in, MR, 12288, 4096}; pg8::StaticOrder S; S.init(MR, 12288, G, bx);
        pg8::EpiZ E{QD, KD, VD, GD, CQ, CKV, GM, KR, cosT, sinT, 0.08838834764831845f};
        pg8::gemm_phase<pg8::EpiZ, pg8::StaticOrder, false, true>((LAS unsigned char*)lds, g, S, E, wave);
    }
    SEAM(1);
    if (IN(2)) {
        f32x4 gq[6], gk[2];
#pragma unroll
        for (int j = 0; j < 3; ++j) { gq[2 * j] = *(const f32x4*)(g_cq + 512 * j + 8 * lane); gq[2 * j + 1] = *(const f32x4*)(g_cq + 512 * j + 8 * lane + 4); }
        gk[0] = *(const f32x4*)(g_ckv + 8 * lane); gk[1] = *(const f32x4*)(g_ckv + 8 * lane + 4);
        for (int rep_ = 0; rep_ < (REP(9) == 2 ? hi_ph - 6 : 1); ++rep_) if (G == 256) { LAS float* red = (LAS float*)lds; const int c = lane & 15, q = lane >> 4;
            if (vcu < 208) { const int r0 = 80 * vcu; f32x4 res[5];
                wg_task<5, 4>(XN + (size_t)r0 * 4096, Wt_in + (size_t)12288 * 4096, red, res, wave, lane);
                if (wave < 4) {
#pragma unroll
                    for (int rb = 0; rb < 5; ++rb)
#pragma unroll
                        for (int rg = 0; rg < 4; ++rg) { const int row = r0 + 16 * rb + 4 * q + rg, pos = row < MR ? 16 + (row & 4095) : ((row - MR) & 63), col = 16 * wave + c;
                            const float xs = res[rb][rg], xo = __shfl_xor(xs, 1), cs = cosT[pos * 32 + (col >> 1)], sn = sinT[pos * 32 + (col >> 1)];
                            if ((c & 1) == 0) *(unsigned*)(KR + (size_t)row * 64 + col) = pk2(xs * cs - xo * sn, xs * sn + xo * cs); } }
            } else if (vcu < 240) { const int tsk = vcu - 208, isv = tsk >> 4, n0 = (isv ? 4096 : 2048) + 128 * (tsk & 15); f32x4 res[2];
                wg_task<1, 8>(XN + (size_t)MR * 4096, Wt_in + (size_t)n0 * 4096, red, res, wave, lane);
                bf16* dst = (isv ? VD : KD) + (size_t)(tsk & 15) * MP * 128;
                if (wave < 4) {
#pragma unroll
                    for (int r = 0; r < 2; ++r)
#pragma unroll
                        for (int rg = 0; rg < 4; ++rg) { const int d = 16 * (4 * r + wave) + c; const float xs = res[r][rg], xo = __shfl_xor(xs, 1);
                            if ((c & 1) == 0) { const unsigned w = pk2(xs, xo);
#pragma unroll
                                for (int b = 0; b < 4; ++b) *(unsigned*)(dst + ((size_t)MR + 64 * b + 4 * q + rg) * 128 + d) = w; } } }
            } else if (vcu < 244) { const int tsk = vcu - 240; f32x4 res[2];
                wg_task<1, 8>(XN + (size_t)MR * 4096, Wt_in + (size_t)(9728 + 128 * tsk) * 4096, red, res, wave, lane);
                if (wave < 4) {
#pragma unroll
                    for (int r = 0; r < 2; ++r)
#pragma unroll
                        for (int rg = 0; rg < 4; ++rg) CKVM[(4 * q + rg) * 512 + 128 * tsk + 16 * (4 * r + wave) + c] = res[r][rg]; }
            }
        }
        for (int m = gw; m < MR; m += NGW) {
            { v4u* p = (v4u*)(CQ + (size_t)m * Q_LORA) + lane; v4u v[3]; float s = 0.f;
#pragma unroll
                for (int j = 0; j < 3; ++j) { v[j] = p[64 * j];
#pragma unroll
                    for (int e = 0; e < 4; ++e) { const float a = bflo(v[j][e]), b = bfhi(v[j][e]); s += a * a + b * b; } }
                const float rstd = 1.f / sqrtf(wave_sum(s) * (1.f / Q_LORA) + RMS_EPS);
#pragma unroll
                for (int j = 0; j < 3; ++j) { v4u o;
#pragma unroll
                    for (int e = 0; e < 4; ++e) { const f32x4 gg = gq[2 * j + (e >> 1)];
                        o[e] = pk2(bflo(v[j][e]) * rstd * gg[(e & 1) * 2], bfhi(v[j][e]) * rstd * gg[(e & 1) * 2 + 1]); }
                    p[64 * j] = o; } }
            { v4u* p = (v4u*)(CKV + (size_t)m * KV_LORA) + lane; v4u v = p[0]; float s = 0.f;
#pragma unroll
                for (int e = 0; e < 4; ++e) { const float a = bflo(v[e]), b = bfhi(v[e]); s += a * a + b * b; }
                const float rstd = 1.f / sqrtf(wave_sum(s) * (1.f / KV_LORA) + RMS_EPS); v4u o;
#pragma unroll
                for (int e = 0; e < 4; ++e) { const f32x4 gg = gk[e >> 1]; o[e] = pk2(bflo(v[e]) * rstd * gg[(e & 1) * 2], bfhi(v[e]) * rstd * gg[(e & 1) * 2 + 1]); }
                p[0] = o; }
        }
        for (int rep_ = 0; rep_ < REP(10); ++rep_) for (int id = gw; id < 16 * 4 * 64; id += NGW) { const int hm = id >> 8, b = (id >> 6) & 3, tt = (id & 63) + 1;
            const size_t r0 = (size_t)hm * MP + (tt == 0 ? (size_t)MR + 64 * b : (size_t)b * SEQ + 64 * (tt - 1));
            float kmax = 0.f, qmax = 0.f, smin = 3.0e38f;
#pragma unroll 4
            for (int i = 0; i < 16; ++i) { const size_t off = (r0 + 4 * i + (lane >> 4)) * 128 + 8 * (lane & 15);
                const v4u k8 = *(const v4u*)(KD + off); const v4u q8 = tt ? *(const v4u*)(QD + off) : (v4u){0u, 0u, 0u, 0u};
                float kk = 0.f, qq = 0.f, qk = 0.f;
#pragma unroll
                for (int e = 0; e < 4; ++e) { const float k0 = bflo(k8[e]), k1 = bfhi(k8[e]), q0 = bflo(q8[e]), q1 = bfhi(q8[e]); kk += k0 * k0 + k1 * k1; qq += q0 * q0 + q1 * q1; qk += q0 * k0 + q1 * k1; }
#pragma unroll
                for (int o = 1; o < 16; o <<= 1) { kk += __shfl_xor(kk, o); qq += __shfl_xor(qq, o); qk += __shfl_xor(qk, o); }
                kmax = fmaxf(kmax, kk); qmax = fmaxf(qmax, qq); smin = fminf(smin, qk); }
            kmax = fmaxf(kmax, __shfl_xor(kmax, 16)); kmax = fmaxf(kmax, __shfl_xor(kmax, 32));
            qmax = fmaxf(qmax, __shfl_xor(qmax, 16)); qmax = fmaxf(qmax, __shfl_xor(qmax, 32));
            smin = fminf(smin, __shfl_xor(smin, 16)); smin = fminf(smin, __shfl_xor(smin, 32));
            if (lane == 0) { KN2[(hm * 4 + b) * 65 + tt] = kmax; if (tt) { QST[((hm * 4 + b) * 64 + tt - 1) * 2] = qmax; QST[((hm * 4 + b) * 64 + tt - 1) * 2 + 1] = smin; } }
        }
    }
    SEAM(2);
    if (IN(3)) for (int rep_ = 0; rep_ < REP(3); ++rep_) {
        if (rep_ == 0 && gw < 64) { const int c = lane & 15, q = lane >> 4; f32x4 acc[4];
            const float* xrow = CKVM + c * 512 + 8 * q; float ss = 0.f;
#pragma unroll
            for (int s = 0; s < 16; ++s) { const f32x4 x0 = *(const f32x4*)(xrow + 32 * s), x1 = *(const f32x4*)(xrow + 32 * s + 4);
                ss += (x0[0] * x0[0] + x0[1] * x0[1]) + (x0[2] * x0[2] + x0[3] * x0[3]) + (x1[0] * x1[0] + x1[1] * x1[1]) + (x1[2] * x1[2] + x1[3] * x1[3]); }
            ss += __shfl_xor(ss, 16); ss += __shfl_xor(ss, 32);
            const float rstd = 1.f / sqrtf(ss * (1.f / KV_LORA) + RMS_EPS);
            const bf16* bp = Wt_ukv + (size_t)(64 * gw + c) * KV_LORA + 8 * q;
#pragma unroll
            for (int nb = 0; nb < 4; ++nb) acc[nb] = (f32x4){0.f, 0.f, 0.f, 0.f};
#pragma unroll 4
            for (int s = 0; s < 16; ++s) { const f32x4 x0 = *(const f32x4*)(xrow + 32 * s), x1 = *(const f32x4*)(xrow + 32 * s + 4);
                const f32x4 g0 = *(const f32x4*)(g_ckv + 32 * s + 8 * q), g1 = *(const f32x4*)(g_ckv + 32 * s + 8 * q + 4);
                v4u aw; aw.x = pk2(x0[0] * rstd * g0[0], x0[1] * rstd * g0[1]); aw.y = pk2(x0[2] * rstd * g0[2], x0[3] * rstd * g0[3]);
                aw.z = pk2(x1[0] * rstd * g1[0], x1[1] * rstd * g1[1]); aw.w = pk2(x1[2] * rstd * g1[2], x1[3] * rstd * g1[3]);
                const bf16x8 a = __builtin_bit_cast(bf16x8, aw);
#pragma unroll
                for (int nb = 0; nb < 4; ++nb) { const bf16x8 b = *(const bf16x8*)(bp + (size_t)nb * 16 * KV_LORA + 32 * s); acc[nb] = __builtin_amdgcn_mfma_f32_16x16x32_bf16(a, b, acc[nb], 0, 0, 0); } }
#pragma unroll
            for (int nb = 0; nb < 4; ++nb)
#pragma unroll
                for (int rg = 0; rg < 4; ++rg) { const int nn = 64 * gw + 16 * nb + c, hh = nn >> 7, d = nn & 127;
                    const float xs = acc[nb][rg], xo = __shfl_xor(xs, 1);
                    if ((c & 1) == 0) { const unsigned w = pk2(xs, xo);
#pragma unroll
                        for (int b = 0; b < 4; ++b) *(unsigned*)(KV + ((size_t)hh * MP + MR + 64 * b + 4 * q + rg) * 128 + d) = w; } }
        }
        { pg8::Gemm g{CQ, Wt_uq, MR, 3072, Q_LORA}; pg8::StaticOrder S; S.init(MR, 3072, G, bx);
          pg8::EpiQ E{QN, QR, cosT, sinT, 0.07216878364870323f * LOG2E};
          pg8::gemm_phase<pg8::EpiQ, pg8::StaticOrder, false, true>((LAS unsigned char*)lds, g, S, E, wave); }
        { pg8::Gemm g{CKV, Wt_ukv, MR, 4096, KV_LORA}; pg8::StaticOrder S; S.init(MR, 4096, G, bx);
          pg8::EpiKV E{KV};
          pg8::gemm_phase<pg8::EpiKV, pg8::StaticOrder, false, true>((LAS unsigned char*)lds, g, S, E, wave); }
    }
    SEAM(3);
    if (IN(4)) {
        unsigned* qctr = (unsigned*)(ws + WS_CTL) + 3600;
        volatile LAS unsigned* qslot = (volatile LAS unsigned*)((LAS unsigned char*)lds + MISC_OFF) + 16;
        if (tid == 0) { const unsigned t_ = __hip_atomic_fetch_add(qctr, 1u, __ATOMIC_RELAXED, __HIP_MEMORY_SCOPE_AGENT); qslot[0] = t_ < 3072u ? (unsigned)ATT_ORDER[t_] : 0xffffffffu; }
        for (;;) {
            __syncthreads();
            const unsigned code = (unsigned)__builtin_amdgcn_readfirstlane((int)qslot[0]);
            __syncthreads();
            if (code == 0xffffffffu) break;
            unsigned nxt_ = 0u;
            if (tid == 0) nxt_ = __hip_atomic_fetch_add(qctr, 1u, __ATOMIC_RELAXED, __HIP_MEMORY_SCOPE_AGENT);
            att::Unit u;
            if (!(code & 0x8000u)) { const int qb = code & 31, mp = (code >> 5) & 1, h = (code >> 6) & 7, b = (code >> 9) & 3; att::UnitX ux;
                const size_t qrow = (size_t)b * SEQ + (size_t)qb * 128, mrow = (size_t)MR + 64 * b, hq = (size_t)(h * 2 + mp) * MP, hv0 = (size_t)(h * 2) * MP, hv1 = (size_t)(h * 2 + 1) * MP;
                ux.Q = QD + (hq + qrow) * 128; ux.Kr = KD + (hq + (size_t)b * SEQ) * 128; ux.Km = KD + (hq + mrow) * 128;
                ux.V0r = VD + (hv0 + (size_t)b * SEQ) * 128; ux.V0m = VD + (hv0 + mrow) * 128; ux.V1r = VD + (hv1 + (size_t)b * SEQ) * 128; ux.V1m = VD + (hv1 + mrow) * 128;
                ux.O = (mp ? O2 : O1) + qrow * 2048 + h * 256; ux.qb = qb; ux.nslope = -exp2f(-(float)(h + 1)); ux.kn2 = KN2 + ((h * 2 + mp) * 4 + b) * 65; ux.qst = QST + ((h * 2 + mp) * 4 + b) * 128;
                att::attn_unit_x<2048>(ux, (char*)lds, wave);
            } else { const int qb = code & 15, h = (code >> 4) & 15, b = (code >> 8) & 3;
                const size_t qrow = (size_t)b * SEQ + (size_t)qb * 256, mrow = (size_t)MR + 64 * b, hk = (size_t)(2 * h) * MP, hv = (size_t)(2 * h + 1) * MP;
                u.Q = QN + ((size_t)h * MR + qrow) * 128; u.Q2 = QR + ((size_t)h * MR + qrow) * 64;
                u.Kr = KV + (hk + (size_t)b * SEQ) * 128; u.Km = KV + (hk + mrow) * 128;
                u.K2r = KR + (size_t)b * SEQ * 64; u.K2m = KR + mrow * 64;
                u.Vr = KV + (hv + (size_t)b * SEQ) * 128; u.Vm = KV + (hv + mrow) * 128;
                u.O = OB + qrow * 2048 + h * 128; u.qb = qb; u.nslope2 = 0.f; u.kn2 = nullptr; u.qst = nullptr;
                att::attn_unit<true, false, 128, 64, 128, 128, 2048>(u, (char*)lds, wave); }
            if (tid == 0) qslot[0] = nxt_ < 3072u ? (unsigned)ATT_ORDER[nxt_] : 0xffffffffu;
        }
    }
    SEAM(4);
    if (IN(5)) for (int rep_ = 0; rep_ < REP(5); ++rep_) {
        float lam;
        { const float a = lq1[lane] * lk1[lane] + lq1[lane + 64] * lk1[lane + 64], c = lq2[lane] * lk2[lane] + lq2[lane + 64] * lk2[lane + 64];
          lam = __expf(wave_sum(a)) - __expf(wave_sum(c)) + LAMBDA_INIT; }
        f32x4 sl0 = *(const f32x4*)(subln + (lane & 31) * 8), sl1 = *(const f32x4*)(subln + (lane & 31) * 8 + 4);
        for (int m = gw; m < MR; m += NGW) {
            const v4u* p1 = (const v4u*)(O1 + (size_t)m * 2048) + lane; const v4u* p2 = (const v4u*)(O2 + (size_t)m * 2048) + lane;
            const v4u* pg = (const v4u*)(GD + (size_t)m * 2048) + lane;
            const v4u* pb = (const v4u*)(OB + (size_t)m * 2048) + lane; const v4u* pm = (const v4u*)(GM + (size_t)m * 2048) + lane;
            v4u a[4], b[4], gt[4], ab[4], gm[4];
#pragma unroll
            for (int j = 0; j < 4; ++j) { a[j] = p1[64 * j]; b[j] = p2[64 * j]; gt[j] = pg[64 * j]; ab[j] = pb[64 * j]; gm[j] = pm[64 * j]; }
            v4u* po = (v4u*)(MIX + (size_t)m * 4096) + lane;
#pragma unroll
            for (int j = 0; j < 4; ++j) { float d[8]; float ss = 0.f;
#pragma unroll
                for (int e = 0; e < 4; ++e) { const float d0 = bflo(a[j][e]) - lam * bflo(b[j][e]), d1 = bfhi(a[j][e]) - lam * bfhi(b[j][e]); d[2 * e] = d0; d[2 * e + 1] = d1; ss += d0 * d0 + d1 * d1; }
                ss += __shfl_xor(ss, 1); ss += __shfl_xor(ss, 2); ss += __shfl_xor(ss, 4); ss += __shfl_xor(ss, 8); ss += __shfl_xor(ss, 16);
                const float rstd = (1.f - LAMBDA_INIT) / sqrtf(ss * (1.f / 256.f) + RMS_EPS); v4u o;
#pragma unroll
                for (int e = 0; e < 4; ++e) { const f32x4 s4 = (e >> 1) ? sl1 : sl0;
                    o[e] = pk2(d[2 * e] * rstd * s4[(e & 1) * 2] * silu(bflo(gt[j][e])), d[2 * e + 1] * rstd * s4[(e & 1) * 2 + 1] * silu(bfhi(gt[j][e]))); }
                po[64 * j] = o;
                v4u o2;
#pragma unroll
                for (int e = 0; e < 4; ++e) o2[e] = pk2(bflo(ab[j][e]) * silu(bflo(gm[j][e])), bfhi(ab[j][e]) * silu(bfhi(gm[j][e])));
                po[256 + 64 * j] = o2; }
        }
    }
    SEAM(5);
    if (IN(6)) for (int rep_ = 0; rep_ < REP(6); ++rep_) {
        pg8::Gemm g{MIX, Wt_out, MR, 4096, 4096}; pg8::StaticOrder S; S.init(MR, 4096, G, bx);
        pg8::EpiBf16<0> E{Y16, 4096, nullptr, 0, 0, 1.f};
        pg8::gemm_phase<pg8::EpiBf16<0>, pg8::StaticOrder, false, true>((LAS unsigned char*)lds, g, S, E, wave);
    }
    SEAM(6);
    if (IN(7)) {
        for (int m = gw; m < MR; m += NGW) {
            const v4u* yr = (const v4u*)(Y16 + (size_t)m * D_MODEL) + lane; f32x4* orow = (f32x4*)(out + (size_t)m * D_MODEL) + 2 * lane;
            const f32x4* xr = (const f32x4*)(x + (size_t)m * D_MODEL) + 2 * lane; const f32x4* gr = (const f32x4*)g_post + 2 * lane;
            v4u v[8]; float s = 0.f;
#pragma unroll
            for (int j = 0; j < 8; ++j) { v[j] = yr[64 * j];
#pragma unroll
                for (int e = 0; e < 4; ++e) { const float a = bflo(v[j][e]), b = bfhi(v[j][e]); s += a * a + b * b; } }
            const float rstd = 1.f / sqrtf(wave_sum(s) * (1.f / D_MODEL) + RMS_EPS);
#pragma unroll
            for (int j = 0; j < 8; ++j) { const f32x4 g0 = gr[128 * j], g1 = gr[128 * j + 1], x0 = __builtin_nontemporal_load(xr + 128 * j), x1 = __builtin_nontemporal_load(xr + 128 * j + 1);
                f32x4 y0 = {bflo(v[j][0]), bfhi(v[j][0]), bflo(v[j][1]), bfhi(v[j][1])}, y1 = {bflo(v[j][2]), bfhi(v[j][2]), bflo(v[j][3]), bfhi(v[j][3])};
                __builtin_nontemporal_store(x0 + y0 * rstd * g0, orow + 128 * j); __builtin_nontemporal_store(x1 + y1 * rstd * g1, orow + 128 * j + 1); }
        }
    }
#undef IN
#undef SEAM
#undef lane
#undef tid
}

extern "C" void kernel_launch(void* const* d_in, const int* in_sizes, int n_in, void* d_out, int out_size, void* d_ws, size_t ws_size, hipStream_t stream) {
    static int grid = 0;
    if (grid == 0) {
        if (n_in != 15 || out_size != MR * D_MODEL || ws_size < WS_END) { fprintf(stderr, "kernel_launch: unexpected shapes (n_in %d out %d ws %zu)\n", n_in, out_size, ws_size); grid = -1; return; }
        int dev = 0, cus = 0, per_cu = 0;
        (void)hipGetDevice(&dev); (void)hipDeviceGetAttribute(&cus, hipDeviceAttributeMultiprocessorCount, dev);
        if (hipFuncSetAttribute((const void*)hybrid_fwd, hipFuncAttributeMaxDynamicSharedMemorySize, LDS_BYTES) != hipSuccess) { fprintf(stderr, "kernel_launch: hipFuncSetAttribute failed\n"); grid = -1; return; }
        if (hipOccupancyMaxActiveBlocksPerMultiprocessor(&per_cu, (const void*)hybrid_fwd, NWAVES * 64, LDS_BYTES) != hipSuccess || per_cu < 1) per_cu = 1;
        (void)hipGetLastError();
        grid = cus * per_cu;
    }
    if (grid < 0) return;
    if (hipMemsetAsync((char*)d_ws + WS_CTL, 0, CTL_ZERO_BYTES, stream) != hipSuccess) { fprintf(stderr, "kernel_launch: memset failed\n"); return; }
    Args a{};
    for (int i = 0; i < 15; ++i) a.in[i] = (const float*)d_in[i];
    a.out = (float*)d_out; a.ws = (unsigned char*)d_ws; a.ph_lo = 0; a.ph_hi = 8;
    void* kargs[] = {&a};
    hipError_t e = hipLaunchCooperativeKernel((const void*)hybrid_fwd, dim3(grid), dim3(NWAVES * 64), kargs, LDS_BYTES, stream);
    if (e != hipSuccess) fprintf(stderr, "kernel_launch: cooperative launch failed: %s (grid %d)\n", hipGetErrorString(e), grid);
}
```
